# Optimizing an MI355X kernel written in HIP

```python
import jax
import jax.numpy as jnp
from jax import lax
import numpy as np

D_MODEL = 4096
BATCH = 2
SEQ = 8192
DEPTH = 1

GRID_W = 64
CTX_LEN = 256

D_RWKV = D_MODEL // 2
RWKV_HEAD = 64
RWKV_HEADS = D_RWKV // RWKV_HEAD
DECAY_LORA = 96
ICLR_LORA = 96
GATE_LORA = 256
GN_EPS = 64e-5

ATT_HEAD = 128
ATT_HEADS = (D_MODEL // 2) // ATT_HEAD
ATT_KV_HEADS = 4
ATT_GROUPS = ATT_HEADS // ATT_KV_HEADS
D_ATT = ATT_HEADS * ATT_HEAD
D_ATT_KV = ATT_KV_HEADS * ATT_HEAD
WINDOW = 128
BLOCK = 128
ROPE_BASE = 10000.0

D_FF = -(-(8 * D_MODEL) // (3 * 256)) * 256

LN_EPS = 1e-5
DEEPNORM_ALPHA = (2 * DEPTH) ** 0.25
DEEPNORM_BETA = (8 * DEPTH) ** -0.25
NEG_INF = -1e30

N_RWKV_COLS = 3 * D_RWKV + 2 * DECAY_LORA + 2 * ICLR_LORA + GATE_LORA
N_IN = N_RWKV_COLS + D_ATT + 2 * D_ATT_KV + 2 * D_MODEL
IN_SPLIT = (N_RWKV_COLS, N_RWKV_COLS + D_ATT, N_RWKV_COLS + D_ATT + D_ATT_KV,
            N_RWKV_COLS + D_ATT + 2 * D_ATT_KV, N_RWKV_COLS + D_ATT + 2 * D_ATT_KV + D_MODEL)
RWKV_SPLIT = (D_RWKV, 2 * D_RWKV, 3 * D_RWKV, 3 * D_RWKV + 2 * DECAY_LORA,
              3 * D_RWKV + 2 * DECAY_LORA + 2 * ICLR_LORA)

kernel_name = 'hybrid_rwkv7_swa_dit_block'


def layer_norm(x, g, b):
    xf = x.astype(jnp.float32)
    mu = jnp.mean(xf, -1, keepdims=True)
    var = jnp.mean(jnp.square(xf - mu), -1, keepdims=True)
    return ((xf - mu) * lax.rsqrt(var + LN_EPS) * g + b).astype(x.dtype)


def centred_conv3(x, w):
    xp = jnp.pad(x, ((0, 0), (1, 1), (0, 0)))
    return xp[:, :-2] * w[0] + xp[:, 1:-1] * w[1] + xp[:, 2:] * w[2]


def axial_rope(T):
    rows = T // GRID_W
    row = jnp.broadcast_to(jnp.arange(rows, dtype=jnp.float32)[:, None], (rows, GRID_W)).reshape(T)
    col = jnp.broadcast_to(jnp.arange(GRID_W, dtype=jnp.float32)[None, :], (rows, GRID_W)).reshape(T)
    axis_dim = ATT_HEAD // 2
    inv = ROPE_BASE ** (-jnp.arange(0, axis_dim, 2, dtype=jnp.float32) / axis_dim)
    ang = jnp.concatenate([row[:, None] * inv, col[:, None] * inv], -1)
    return jnp.cos(ang)[None, :, None, :], jnp.sin(ang)[None, :, None, :]


def apply_rope(x, cos, sin):
    xf = x.astype(jnp.float32)
    x1, x2 = xf[..., :ATT_HEAD // 2], xf[..., ATT_HEAD // 2:]
    return jnp.concatenate([x1 * cos - x2 * sin, x2 * cos + x1 * sin], -1).astype(x.dtype)


def heads64(t):
    return t.reshape(t.shape[:-1] + (RWKV_HEADS, RWKV_HEAD))


def rwkv_features(cols, shift_w, w0, w_up, a0, a_up, g_up, k_k, k_a):
    B, T = cols.shape[:2]
    x = centred_conv3(cols, shift_w)
    r, k, v, wd, ad, gd = jnp.split(x, RWKV_SPLIT, axis=-1)
    wd = wd.reshape(B, T, 2, DECAY_LORA)
    ad = ad.reshape(B, T, 2, ICLR_LORA)
    w_log = -jax.nn.softplus(-(w0 + jnp.einsum('btdr,drc->btdc', jnp.tanh(wd), w_up))) - 0.5
    decay = jnp.exp(-jnp.exp(w_log.astype(jnp.float32)))
    iclr = jax.nn.sigmoid(a0 + jnp.einsum('btdr,drc->btdc', ad, a_up))
    kk = heads64((k * k_k).astype(jnp.float32))
    kk = kk / jnp.maximum(jnp.linalg.norm(kk, axis=-1, keepdims=True), 1e-12)
    k_dir = k[:, :, None, :] * (1.0 + (iclr - 1.0) * k_a)
    b = kk[:, :, None] * heads64(iclr).astype(jnp.float32)
    g = jax.nn.sigmoid(gd) @ g_up
    return heads64(r), heads64(v), g, heads64(decay), heads64(k_dir), kk, b


def rwkv7_scan(state, r, decay, k, v, kk, b, reverse, with_outputs):
    def step(S, inp):
        r_t, w_t, k_t, v_t, kk_t, b_t = inp
        sa = jnp.einsum('bhvk,bhk->bhv', S, kk_t)
        S = S * w_t[:, :, None, :] - sa[..., None] * b_t[:, :, None, :] + v_t[..., None] * k_t[:, :, None, :]
        if with_outputs:
            return S, jnp.einsum('bhvk,bhk->bhv', S, r_t)
        return S, None
    xs = tuple(jnp.moveaxis(t.astype(jnp.float32), 1, 0) for t in (r, decay, k, v, kk, b))
    S, ys = lax.scan(step, state, xs, reverse=reverse)
    if with_outputs:
        ys = jnp.moveaxis(ys, 0, 1)
    return S, ys


def rwkv_output(y_fwd, y_bwd, r, k_dir, v, g, r_k, gn_g, gn_b):
    B, T = g.shape[:2]
    y = y_fwd + y_bwd
    mu = jnp.mean(y, -1, keepdims=True)
    var = jnp.mean(jnp.square(y - mu), -1, keepdims=True)
    yn = ((y - mu) * lax.rsqrt(var + GN_EPS)).reshape(B, T, D_RWKV) * gn_g + gn_b
    k_sum = (k_dir[:, :, 0] + k_dir[:, :, 1]).astype(jnp.float32)
    bonus = jnp.sum(r.astype(jnp.float32) * k_sum * r_k, -1, keepdims=True) * v.astype(jnp.float32)
    return ((yn + bonus.reshape(B, T, D_RWKV)) * g).astype(g.dtype)


def windowed_attention(q, k, v, k_ctx, v_ctx, sink):
    B, T = q.shape[:2]
    L = k_ctx.shape[1]
    nb = T // BLOCK
    qb = q.reshape(B, nb, BLOCK, ATT_KV_HEADS, ATT_GROUPS, ATT_HEAD)
    pad = ((0, 0), (BLOCK, BLOCK), (0, 0), (0, 0))
    kp = jnp.pad(k, pad).reshape(B, nb + 2, BLOCK, ATT_KV_HEADS, ATT_HEAD)
    vp = jnp.pad(v, pad).reshape(B, nb + 2, BLOCK, ATT_KV_HEADS, ATT_HEAD)
    band = lambda t: jnp.concatenate([t[:, :-2], t[:, 1:-1], t[:, 2:]], axis=2)
    kw, vw = band(kp), band(vp)
    scale = ATT_HEAD ** -0.5
    s_win = jnp.einsum('bnqhgd,bnkhd->bnhgqk', qb, kw).astype(jnp.float32) * scale
    q_off = jnp.arange(BLOCK)[:, None]
    k_off = jnp.arange(3 * BLOCK)[None, :] - BLOCK
    in_window = jnp.abs(q_off - k_off) <= WINDOW
    k_abs = jnp.arange(nb)[:, None] * BLOCK + k_off
    in_seq = (k_abs >= 0) & (k_abs < T)
    mask = in_window[None] & in_seq[:, None, :]
    s_win = jnp.where(mask[None, :, None, None], s_win, NEG_INF)
    s_ctx = jnp.einsum('bnqhgd,blhd->bnhgql', qb, k_ctx).astype(jnp.float32) * scale
    s_sink = jnp.broadcast_to(sink.astype(jnp.float32).reshape(ATT_KV_HEADS, ATT_GROUPS)[None, None, :, :, None, None],
                              s_win.shape[:-1] + (1,))
    p = jax.nn.softmax(jnp.concatenate([s_win, s_ctx, s_sink], -1), axis=-1).astype(v.dtype)
    nw = 3 * BLOCK
    o = (jnp.einsum('bnhgqk,bnkhd->bnqhgd', p[..., :nw], vw)
         + jnp.einsum('bnhgql,blhd->bnqhgd', p[..., nw:nw + L], v_ctx))
    return o.reshape(B, T, D_ATT)


def context_attention(q_c, k_c, v_c, sink):
    B, L = q_c.shape[:2]
    qg = q_c.reshape(B, L, ATT_KV_HEADS, ATT_GROUPS, ATT_HEAD)
    s = jnp.einsum('bqhgd,bkhd->bhgqk', qg, k_c).astype(jnp.float32) * ATT_HEAD ** -0.5
    s_sink = jnp.broadcast_to(sink.astype(jnp.float32).reshape(ATT_KV_HEADS, ATT_GROUPS)[None, :, :, None, None],
                              s.shape[:-1] + (1,))
    p = jax.nn.softmax(jnp.concatenate([s, s_sink], -1), axis=-1)[..., :L].astype(v_c.dtype)
    return jnp.einsum('bhgqk,bkhd->bqhgd', p, v_c).reshape(B, L, D_ATT)


def merge_branches(o_rwkv, o_att, gate_r, gate_a, w_rwkv_o, w_att_o, w_out):
    y = jax.nn.sigmoid(gate_r) * (o_rwkv @ w_rwkv_o) + jax.nn.sigmoid(gate_a) * (o_att @ w_att_o)
    return y @ w_out


def token_mixer(h, h_c, cos, sin, w_in, shift_w, w0, w_up, a0, a_up, g_up, k_k, k_a, r_k, gn_g, gn_b,
                sink, w_rwkv_o, w_att_o, w_out, ctx_out):
    B, T = h.shape[:2]
    L = h_c.shape[1]
    rw, q, k, v, gate_r, gate_a = jnp.split(h @ w_in, IN_SPLIT, axis=-1)
    rw_c, q_c, k_c, v_c, gate_r_c, gate_a_c = jnp.split(h_c @ w_in, IN_SPLIT, axis=-1)

    r, vr, g, decay, k_dir, kk, b = rwkv_features(rw, shift_w, w0, w_up, a0, a_up, g_up, k_k, k_a)
    r_c, vr_c, g_c, decay_c, k_dir_c, kk_c, b_c = rwkv_features(rw_c, shift_w, w0, w_up, a0, a_up, g_up, k_k, k_a)
    zero = jnp.zeros((B, RWKV_HEADS, RWKV_HEAD, RWKV_HEAD), jnp.float32)
    ys, ys_c = [], []
    for d in range(2):
        rev = d == 1
        S_c, y_c = rwkv7_scan(zero, r_c, decay_c[:, :, d], k_dir_c[:, :, d], vr_c, kk_c, b_c[:, :, d], rev, ctx_out)
        _, y = rwkv7_scan(S_c, r, decay[:, :, d], k_dir[:, :, d], vr, kk, b[:, :, d], rev, True)
        ys.append(y)
        ys_c.append(y_c)
    o_rwkv = rwkv_output(ys[0], ys[1], r, k_dir, vr, g, r_k, gn_g, gn_b)

    qh = apply_rope(q.reshape(B, T, ATT_HEADS, ATT_HEAD), cos, sin)
    kh = apply_rope(k.reshape(B, T, ATT_KV_HEADS, ATT_HEAD), cos, sin)
    vh = v.reshape(B, T, ATT_KV_HEADS, ATT_HEAD)
    kc = k_c.reshape(B, L, ATT_KV_HEADS, ATT_HEAD)
    vc = v_c.reshape(B, L, ATT_KV_HEADS, ATT_HEAD)
    o_att = windowed_attention(qh, kh, vh, kc, vc, sink)

    y = merge_branches(o_rwkv, o_att, gate_r, gate_a, w_rwkv_o, w_att_o, w_out)
    if not ctx_out:
        return y, None
    o_rwkv_c = rwkv_output(ys_c[0], ys_c[1], r_c, k_dir_c, vr_c, g_c, r_k, gn_g, gn_b)
    o_att_c = context_attention(q_c.reshape(B, L, ATT_HEADS, ATT_HEAD), kc, vc, sink)
    y_c = merge_branches(o_rwkv_c, o_att_c, gate_r_c, gate_a_c, w_rwkv_o, w_att_o, w_out)
    return y, y_c


def swiglu(h, w_gate, w_up, w_down):
    return (jax.nn.silu(h @ w_gate) * (h @ w_up)) @ w_down


def setup_inputs(seed: int = 0) -> dict:
    key = jax.random.key(seed)
    ks = iter(jax.random.split(key, 40))

    def nrm(shape, scale):
        return scale * jax.random.normal(next(ks), shape, jnp.float32)

    C = D_RWKV
    return {
        'x': nrm((BATCH, SEQ, D_MODEL), 1.0),
        'c': nrm((BATCH, D_MODEL), 1.0),
        'ctx': nrm((BATCH, CTX_LEN, D_MODEL), 1.0),
        'c_ctx': nrm((D_MODEL,), 1.0),
        'w_ada': nrm((DEPTH, D_MODEL, 6 * D_MODEL), 0.5 * D_MODEL ** -0.5),
        'b_ada': nrm((DEPTH, 6 * D_MODEL), 0.02),
        'w_in': nrm((DEPTH, D_MODEL, N_IN), D_MODEL ** -0.5),
        'rwkv_shift': nrm((DEPTH, 3, N_RWKV_COLS), 0.2) + jnp.array([0.0, 1.0, 0.0], jnp.float32)[None, :, None],
        'rwkv_w0': jax.random.uniform(next(ks), (DEPTH, 2, C), jnp.float32, -6.0, -1.0),
        'rwkv_w_up': nrm((DEPTH, 2, DECAY_LORA, C), 0.3 * DECAY_LORA ** -0.5),
        'rwkv_a0': nrm((DEPTH, 2, C), 0.5),
        'rwkv_a_up': nrm((DEPTH, 2, ICLR_LORA, C), ICLR_LORA ** -0.5),
        'rwkv_g_up': nrm((DEPTH, GATE_LORA, C), GATE_LORA ** -0.5),
        'rwkv_k_k': 0.85 + nrm((DEPTH, C), 0.05),
        'rwkv_k_a': 1.0 + nrm((DEPTH, C), 0.05),
        'rwkv_r_k': nrm((DEPTH, RWKV_HEADS, RWKV_HEAD), 0.1),
        'rwkv_gn_g': 1.0 + nrm((DEPTH, C), 0.02),
        'rwkv_gn_b': nrm((DEPTH, C), 0.02),
        'attn_sink': nrm((DEPTH, ATT_HEADS), 0.5),
        'w_rwkv_o': nrm((DEPTH, C, D_MODEL), C ** -0.5),
        'w_att_o': nrm((DEPTH, D_ATT, D_MODEL), D_ATT ** -0.5),
        'w_out': nrm((DEPTH, D_MODEL, D_MODEL), DEEPNORM_BETA * D_MODEL ** -0.5),
        'ln1_g': 1.0 + nrm((DEPTH, D_MODEL), 0.02),
        'ln1_b': nrm((DEPTH, D_MODEL), 0.02),
        'w_ff_gate': nrm((DEPTH, D_MODEL, D_FF), D_MODEL ** -0.5),
        'w_ff_up': nrm((DEPTH, D_MODEL, D_FF), D_MODEL ** -0.5),
        'w_ff_down': nrm((DEPTH, D_FF, D_MODEL), DEEPNORM_BETA * D_FF ** -0.5),
        'ln2_g': 1.0 + nrm((DEPTH, D_MODEL), 0.02),
        'ln2_b': nrm((DEPTH, D_MODEL), 0.02),
    }


def reference(x, c, ctx, c_ctx, w_ada, b_ada, w_in, rwkv_shift, rwkv_w0, rwkv_w_up, rwkv_a0, rwkv_a_up,
              rwkv_g_up, rwkv_k_k, rwkv_k_a, rwkv_r_k, rwkv_gn_g, rwkv_gn_b, attn_sink, w_rwkv_o, w_att_o,
              w_out, ln1_g, ln1_b, w_ff_gate, w_ff_up, w_ff_down, ln2_g, ln2_b):
    T = x.shape[1]
    cos, sin = axial_rope(T)
    x_c = ctx
    for l in range(DEPTH):
        last = l == DEPTH - 1
        sh1, sc1, gt1, sh2, sc2, gt2 = jnp.split((jax.nn.silu(c) @ w_ada[l] + b_ada[l])[:, None, :], 6, axis=-1)
        sh1c, sc1c, gt1c, sh2c, sc2c, gt2c = jnp.split(jax.nn.silu(c_ctx) @ w_ada[l] + b_ada[l], 6, axis=-1)

        h = x * (1.0 + sc1) + sh1
        h_c = x_c * (1.0 + sc1c) + sh1c
        y, y_c = token_mixer(h, h_c, cos, sin, w_in[l], rwkv_shift[l], rwkv_w0[l], rwkv_w_up[l], rwkv_a0[l],
                             rwkv_a_up[l], rwkv_g_up[l], rwkv_k_k[l], rwkv_k_a[l], rwkv_r_k[l], rwkv_gn_g[l],
                             rwkv_gn_b[l], attn_sink[l], w_rwkv_o[l], w_att_o[l], w_out[l], not last)
        x = layer_norm(DEEPNORM_ALPHA * x + gt1 * y, ln1_g[l], ln1_b[l])

        h = x * (1.0 + sc2) + sh2
        x = layer_norm(DEEPNORM_ALPHA * x + gt2 * swiglu(h, w_ff_gate[l], w_ff_up[l], w_ff_down[l]), ln2_g[l], ln2_b[l])

        if not last:
            x_c = layer_norm(DEEPNORM_ALPHA * x_c + gt1c * y_c, ln1_g[l], ln1_b[l])
            h_c = x_c * (1.0 + sc2c) + sh2c
            x_c = layer_norm(DEEPNORM_ALPHA * x_c + gt2c * swiglu(h_c, w_ff_gate[l], w_ff_up[l], w_ff_down[l]),
                             ln2_g[l], ln2_b[l])
    return x
```

```cpp
#include <hip/hip_runtime.h>
#include <cstdio>
#include <cstdint>
#define LAS __attribute__((address_space(3)))
namespace pg8 {
#define PG8_LAS __attribute__((address_space(3)))
typedef unsigned short bf16_t;
typedef short bf16x8 __attribute__((ext_vector_type(8)));
typedef float f32x4 __attribute__((ext_vector_type(4)));
typedef unsigned u32x4 __attribute__((ext_vector_type(4)));
constexpr int BM = 256, BK = 64, HALF = 128, HTB = HALF * BK * 2  , STAGE_BYTES = 8 * HTB, NXCD = 8, WGM = 8;

__host__ __device__ __forceinline__ int lds_byte(int r, int c) { const int st = (r >> 4) * 2 + (c >> 5), rr = r & 15, cc = c & 31, ob = rr * 64 + cc * 2; return st * 1024 + (ob ^ (((ob >> 9) & 1) << 5)); }
__host__ __device__ __forceinline__ void stage_rc(int b, int& R, int& C) { const int st = b / 1024, sb = b % 1024, swz = sb ^ (((sb >> 9) & 1) << 5); R = (st >> 1) * 16 + swz / 64; C = (st & 1) * 32 + (swz % 64) / 2; }
__host__ __device__ __forceinline__ int perm32(int rho) { const int n = rho >> 4, i = rho & 15; return 8 * (i >> 2) + 4 * n + (i & 3); }

struct Unit { int pm, pn; };
struct Gemm { const bf16_t* A; const bf16_t* Bt; int M, N, K, lda, ldb; };

struct StaticOrder {
    int nM, nN, nwg, G, c;
    __host__ __device__ void init(int M, int N, int G_, int c_) { nM = M / BM; nN = N / BM; nwg = nM * nN; G = G_; c = c_; }
    __host__ __device__ bool next(int i, Unit& u) const {
        const long L = (long)i * G + c; if (L >= nwg) return false;
        int wgid = (int)L; { const int q = nwg / NXCD, r = nwg % NXCD, xcd = wgid % NXCD, off = wgid / NXCD; wgid = (xcd < r ? xcd * (q + 1) : r * (q + 1) + (xcd - r) * q) + off; }
        const int nig = WGM * nN, gid = wgid / nig, fm = gid * WGM, gsz = (nM - fm) < WGM ? (nM - fm) : WGM;
        u.pm = fm + ((wgid % nig) % gsz); u.pn = (wgid % nig) / gsz; return true;
    }
    __device__ __forceinline__ void a_ready(const Unit&) const {}
    __device__ __forceinline__ void done(const Unit&) const {}
};

struct InprojOrder {
    StaticOrder lat; int G, c;
    __host__ __device__ void init(int G_, int c_) { lat.init(64 * BM, 71 * BM, G_, c_); G = G_; c = c_; }
    __host__ __device__ bool next(int i, Unit& u) const {
        const long L = (long)i * G + c; if (L < lat.nwg) return lat.next(i, u);
        const int j = (int)(L - lat.nwg); if (j >= 62) return false;
        const int jj = j % 31; u.pm = 64 + j / 31; u.pn = jj < 27 ? jj : jj + 8; return true;
    }
    __device__ __forceinline__ void a_ready(const Unit&) const {}
    __device__ __forceinline__ void done(const Unit&) const {}
};

typedef float f32x2c __attribute__((ext_vector_type(2)));
typedef __bf16 bf16x2c __attribute__((ext_vector_type(2)));
__device__ __forceinline__ unsigned cvt_pk_bf16(float lo, float hi) { const f32x2c v = {lo, hi}; return __builtin_bit_cast(unsigned, __builtin_convertvector(v, bf16x2c)); }
__device__ __forceinline__ float bflo(unsigned w) { return __uint_as_float(w << 16); }
__device__ __forceinline__ float bfhi(unsigned w) { return __uint_as_float(w & 0xffff0000u); }
__device__ __forceinline__ float sigm(float x) { return __builtin_amdgcn_rcpf(1.0f + __expf(-x)); }

struct EpiInproj {
    static constexpr bool PERM = true, AFTER_DRAIN = false, HAS_MID = false;
    bf16_t *rw, *qkv, *gate; const float* rope;
    __device__ __forceinline__ void operator()(const f32x4 (&acc)[2][2][4][2], const Unit& u, int wr, int wc, int fr, int fq) const {
        bf16_t* base; int ldc, colt;
        if (u.pn < 27) { base = rw; ldc = 6912; colt = u.pn * BM; }
        else if (u.pn < 39) { base = qkv; ldc = 3072; colt = (u.pn - 27) * BM; }
        else { if (u.pm >= 64) return; base = gate; ldc = 8192; colt = (u.pn - 39) * BM; }
        const int row0 = u.pm * BM + wr * 64 + fr, col0 = colt + wc * 32 + 8 * fq;
        const bool rot = u.pm < 64 && u.pn >= 27 && u.pn < 37;
        if (rot) {
            f32x4 cs[4], sn[4];
#define EI_LOAD(g) do { const int t = (row0 + ((g) >> 2) * HALF + ((g) & 3) * 16) & 8191; cs[(g) & 3] = *(const f32x4*)(rope + (size_t)t * 64 + 4 * (4 * wc + fq)); sn[(g) & 3] = *(const f32x4*)(rope + (size_t)(8192 + t) * 64 + 4 * (4 * wc + fq)); } while (0)
            EI_LOAD(0); EI_LOAD(1); EI_LOAD(2); EI_LOAD(3);
#pragma unroll
            for (int g = 0; g < 8; ++g) { const int ai = g >> 2, m = g & 3;
                asm volatile("" : "+v"(cs[g & 3]), "+v"(sn[g & 3]) :: "memory");
                bf16_t* rowp = base + (size_t)(row0 + ai * HALF + m * 16) * ldc + col0; u32x4 w[2];
#pragma unroll
                for (int bj = 0; bj < 2; ++bj) { const f32x4 v0 = acc[ai][bj][m][0], v1 = acc[ai][bj][m][1]; const f32x4 a = v0 * cs[g & 3] - v1 * sn[g & 3], b = v1 * cs[g & 3] + v0 * sn[g & 3];
                    w[bj].x = cvt_pk_bf16(a[0], a[1]); w[bj].y = cvt_pk_bf16(a[2], a[3]); w[bj].z = cvt_pk_bf16(b[0], b[1]); w[bj].w = cvt_pk_bf16(b[2], b[3]); }
                if (g + 4 < 8) EI_LOAD(g + 4);
                *(u32x4*)rowp = w[0]; *(u32x4*)(rowp + HALF) = w[1]; }
#undef EI_LOAD
            return;
        }
#pragma unroll
        for (int ai = 0; ai < 2; ++ai)
#pragma unroll
            for (int m = 0; m < 4; ++m) { bf16_t* rowp = base + (size_t)(row0 + ai * HALF + m * 16) * ldc + col0;
#pragma unroll
                for (int bj = 0; bj < 2; ++bj) { const f32x4 v0 = acc[ai][bj][m][0], v1 = acc[ai][bj][m][1];
                    u32x4 w; w.x = cvt_pk_bf16(v0[0], v0[1]); w.y = cvt_pk_bf16(v0[2], v0[3]); w.z = cvt_pk_bf16(v1[0], v1[1]); w.w = cvt_pk_bf16(v1[2], v1[3]);
                    *(u32x4*)(rowp + bj * HALF) = w; } }
    }
};
struct EpiGate1 {
    static constexpr bool PERM = true, AFTER_DRAIN = false, HAS_MID = false;
    float* T; const bf16_t* gate; int ldg;
    __device__ __forceinline__ void operator()(const f32x4 (&acc)[2][2][4][2], const Unit& u, int wr, int wc, int fr, int fq) const {
        const int row0 = u.pm * BM + wr * 64 + fr, col0 = u.pn * BM + wc * 32 + 8 * fq;
#pragma unroll
        for (int ai = 0; ai < 2; ++ai)
#pragma unroll
            for (int m = 0; m < 4; ++m) { const size_t row = (size_t)(row0 + ai * HALF + m * 16);
#pragma unroll
                for (int bj = 0; bj < 2; ++bj) { const int c = col0 + bj * HALF; const u32x4 gw = *(const u32x4*)(gate + row * ldg + c);
                    const f32x4 v0 = acc[ai][bj][m][0], v1 = acc[ai][bj][m][1];
                    f32x4 o0, o1;
                    o0[0] = sigm(bflo(gw.x)) * v0[0]; o0[1] = sigm(bfhi(gw.x)) * v0[1]; o0[2] = sigm(bflo(gw.y)) * v0[2]; o0[3] = sigm(bfhi(gw.y)) * v0[3];
                    o1[0] = sigm(bflo(gw.z)) * v1[0]; o1[1] = sigm(bfhi(gw.z)) * v1[1]; o1[2] = sigm(bflo(gw.w)) * v1[2]; o1[3] = sigm(bfhi(gw.w)) * v1[3];
                    float* tp = T + row * 4096 + c; *(f32x4*)tp = o0; *(f32x4*)(tp + 4) = o1; } }
    }
};
struct EpiGate2 {
    static constexpr bool PERM = true, AFTER_DRAIN = false, HAS_MID = false;
    const float* T; const bf16_t* gate; int ldg; bf16_t* O;
    __device__ __forceinline__ void operator()(const f32x4 (&acc)[2][2][4][2], const Unit& u, int wr, int wc, int fr, int fq) const {
        const int row0 = u.pm * BM + wr * 64 + fr, col0 = u.pn * BM + wc * 32 + 8 * fq;
#pragma unroll
        for (int ai = 0; ai < 2; ++ai)
#pragma unroll
            for (int m = 0; m < 4; ++m) { const size_t row = (size_t)(row0 + ai * HALF + m * 16);
#pragma unroll
                for (int bj = 0; bj < 2; ++bj) { const int c = col0 + bj * HALF; const u32x4 gw = *(const u32x4*)(gate + row * ldg + c);
                    const float* tp = T + row * 4096 + c; const f32x4 t0 = *(const f32x4*)tp, t1 = *(const f32x4*)(tp + 4);
                    const f32x4 v0 = acc[ai][bj][m][0], v1 = acc[ai][bj][m][1];
                    f32x4 o0, o1;
                    o0[0] = t0[0] + sigm(bflo(gw.x)) * v0[0]; o0[1] = t0[1] + sigm(bfhi(gw.x)) * v0[1]; o0[2] = t0[2] + sigm(bflo(gw.y)) * v0[2]; o0[3] = t0[3] + sigm(bfhi(gw.y)) * v0[3];
                    o1[0] = t1[0] + sigm(bflo(gw.z)) * v1[0]; o1[1] = t1[1] + sigm(bfhi(gw.z)) * v1[1]; o1[2] = t1[2] + sigm(bflo(gw.w)) * v1[2]; o1[3] = t1[3] + sigm(bfhi(gw.w)) * v1[3];
                    u32x4 w; w.x = cvt_pk_bf16(o0[0], o0[1]); w.y = cvt_pk_bf16(o0[2], o0[3]); w.z = cvt_pk_bf16(o1[0], o1[1]); w.w = cvt_pk_bf16(o1[2], o1[3]);
                    *(u32x4*)(O + row * 4096 + c) = w; } }
    }
};
struct EpiResid {
    static constexpr bool PERM = false, AFTER_DRAIN = false, HAS_MID = false;
    const float* X; float* Z; const float* gt; int modstride; float alpha;
    __device__ __forceinline__ void operator()(const f32x4 (&acc)[2][2][4][2], const Unit& u, int wr, int wc, int fr, int fq) const {
        const int row0 = u.pm * BM + wr * 64 + fr, col0 = u.pn * BM + wc * 32 + 4 * fq;
        const float* g = gt + (size_t)((u.pm * BM) >> 13) * modstride;
        f32x4 gv[2][2];
#pragma unroll
        for (int bj = 0; bj < 2; ++bj)
#pragma unroll
            for (int n = 0; n < 2; ++n) gv[bj][n] = *(const f32x4*)(g + col0 + bj * HALF + n * 16);
        f32x4 xb[4][4];
#define ER_LOAD(g_) do { const size_t off_ = (size_t)(row0 + ((g_) >> 2) * HALF + ((g_) & 3) * 16) * 4096 + col0; _Pragma("unroll") for (int bj = 0; bj < 2; ++bj) _Pragma("unroll") for (int n = 0; n < 2; ++n) xb[(g_) & 3][bj * 2 + n] = *(const f32x4*)(X + off_ + bj * HALF + n * 16); } while (0)
        ER_LOAD(0); ER_LOAD(1); ER_LOAD(2); ER_LOAD(3);
#pragma unroll
        for (int gi = 0; gi < 8; ++gi) { const int ai = gi >> 2, m = gi & 3; const size_t off = (size_t)(row0 + ai * HALF + m * 16) * 4096 + col0;
            asm volatile("" : "+v"(xb[gi & 3][0]), "+v"(xb[gi & 3][1]), "+v"(xb[gi & 3][2]), "+v"(xb[gi & 3][3]) :: "memory");
            f32x4 o[4];
#pragma unroll
            for (int bj = 0; bj < 2; ++bj)
#pragma unroll
                for (int n = 0; n < 2; ++n) o[bj * 2 + n] = xb[gi & 3][bj * 2 + n] * alpha + gv[bj][n] * acc[ai][bj][m][n];
            if (gi + 4 < 8) ER_LOAD(gi + 4);
#pragma unroll
            for (int bj = 0; bj < 2; ++bj)
#pragma unroll
                for (int n = 0; n < 2; ++n) *(f32x4*)(Z + off + bj * HALF + n * 16) = o[bj * 2 + n]; }
#undef ER_LOAD
    }
};
struct EpiSwiglu {
    static constexpr bool PERM = true, AFTER_DRAIN = false, HAS_MID = false;
    bf16_t* O; int ldc;
    __device__ __forceinline__ void operator()(const f32x4 (&acc)[2][2][4][2], const Unit& u, int wr, int wc, int fr, int fq) const {
        const int row0 = u.pm * BM + wr * 64 + fr, col0 = u.pn * HALF + wc * 32 + 8 * fq;
#pragma unroll
        for (int ai = 0; ai < 2; ++ai)
#pragma unroll
            for (int m = 0; m < 4; ++m) { bf16_t* rowp = O + (size_t)(row0 + ai * HALF + m * 16) * ldc + col0;
                float o[8];
#pragma unroll
                for (int n = 0; n < 2; ++n)
#pragma unroll
                    for (int e = 0; e < 4; ++e) { const float gg = acc[ai][0][m][n][e], uu = acc[ai][1][m][n][e]; o[n * 4 + e] = gg * sigm(gg) * uu; }
                u32x4 w; w.x = cvt_pk_bf16(o[0], o[1]); w.y = cvt_pk_bf16(o[2], o[3]); w.z = cvt_pk_bf16(o[4], o[5]); w.w = cvt_pk_bf16(o[6], o[7]);
                *(u32x4*)rowp = w; }
    }
};


struct EpiGateMerged {
    static constexpr bool PERM = true, AFTER_DRAIN = false, HAS_MID = true;
    const bf16_t* gate; int ldg; bf16_t* O;
    __device__ __forceinline__ void mid(f32x4 (&acc)[2][2][4][2], const Unit& u, int wr, int wc, int fr, int fq) const {
        int row0 = u.pm * BM + wr * 64 + fr, col0 = u.pn * BM + wc * 32 + 8 * fq; asm volatile("" : "+v"(row0), "+v"(col0));
        u32x4 gr[3][2], ga[3][2];
#define GM_LOAD(i) do { _Pragma("unroll") for (int bj = 0; bj < 2; ++bj) { const bf16_t* p = gate + (size_t)(row0 + ((i) >> 2) * HALF + ((i) & 3) * 16) * ldg + col0 + bj * HALF; gr[(i) % 3][bj] = *(const u32x4*)p; ga[(i) % 3][bj] = *(const u32x4*)(p + 4096); } } while (0)
        GM_LOAD(0); GM_LOAD(1);
#pragma unroll
        for (int i = 0; i < 8; ++i) {
            if (i + 2 < 8) GM_LOAD(i + 2);
            asm volatile("" : "+v"(gr[i % 3][0]), "+v"(gr[i % 3][1]), "+v"(ga[i % 3][0]), "+v"(ga[i % 3][1]) :: "memory");
            const int ai = i >> 2, m = i & 3;
#pragma unroll
            for (int bj = 0; bj < 2; ++bj) { const u32x4 r = gr[i % 3][bj], a = ga[i % 3][bj];
                acc[ai][bj][m][0][0] *= (1.0f + __expf(-bflo(a.x))) * __builtin_amdgcn_rcpf(1.0f + __expf(-bflo(r.x))); acc[ai][bj][m][0][1] *= (1.0f + __expf(-bfhi(a.x))) * __builtin_amdgcn_rcpf(1.0f + __expf(-bfhi(r.x)));
                acc[ai][bj][m][0][2] *= (1.0f + __expf(-bflo(a.y))) * __builtin_amdgcn_rcpf(1.0f + __expf(-bflo(r.y))); acc[ai][bj][m][0][3] *= (1.0f + __expf(-bfhi(a.y))) * __builtin_amdgcn_rcpf(1.0f + __expf(-bfhi(r.y)));
                acc[ai][bj][m][1][0] *= (1.0f + __expf(-bflo(a.z))) * __builtin_amdgcn_rcpf(1.0f + __expf(-bflo(r.z))); acc[ai][bj][m][1][1] *= (1.0f + __expf(-bfhi(a.z))) * __builtin_amdgcn_rcpf(1.0f + __expf(-bfhi(r.z)));
                acc[ai][bj][m][1][2] *= (1.0f + __expf(-bflo(a.w))) * __builtin_amdgcn_rcpf(1.0f + __expf(-bflo(r.w))); acc[ai][bj][m][1][3] *= (1.0f + __expf(-bfhi(a.w))) * __builtin_amdgcn_rcpf(1.0f + __expf(-bfhi(r.w))); }
        }
#undef GM_LOAD
    }
    __device__ __forceinline__ void operator()(const f32x4 (&acc)[2][2][4][2], const Unit& u, int wr, int wc, int fr, int fq) const {
        int row0 = u.pm * BM + wr * 64 + fr, col0 = u.pn * BM + wc * 32 + 8 * fq; asm volatile("" : "+v"(row0), "+v"(col0));
        u32x4 gb[4][2];
#define EG_LOAD(g_) do { const bf16_t* p_ = gate + (size_t)(row0 + ((g_) >> 2) * HALF + ((g_) & 3) * 16) * ldg + 4096 + col0; gb[(g_) & 3][0] = *(const u32x4*)p_; gb[(g_) & 3][1] = *(const u32x4*)(p_ + HALF); } while (0)
        EG_LOAD(0); EG_LOAD(1); EG_LOAD(2); EG_LOAD(3);
#pragma unroll
        for (int gi = 0; gi < 8; ++gi) { const int ai = gi >> 2, m = gi & 3; const size_t row = (size_t)(row0 + ai * HALF + m * 16);
            asm volatile("" : "+v"(gb[gi & 3][0]), "+v"(gb[gi & 3][1]) :: "memory");
            u32x4 w[2];
#pragma unroll
            for (int bj = 0; bj < 2; ++bj) { const u32x4 gw = gb[gi & 3][bj]; const f32x4 v0 = acc[ai][bj][m][0], v1 = acc[ai][bj][m][1];
                w[bj].x = cvt_pk_bf16(sigm(bflo(gw.x)) * v0[0], sigm(bfhi(gw.x)) * v0[1]); w[bj].y = cvt_pk_bf16(sigm(bflo(gw.y)) * v0[2], sigm(bfhi(gw.y)) * v0[3]);
                w[bj].z = cvt_pk_bf16(sigm(bflo(gw.z)) * v1[0], sigm(bfhi(gw.z)) * v1[1]); w[bj].w = cvt_pk_bf16(sigm(bflo(gw.w)) * v1[2], sigm(bfhi(gw.w)) * v1[3]); }
            if (gi + 4 < 8) EG_LOAD(gi + 4);
            *(u32x4*)(O + row * 4096 + col0) = w[0]; *(u32x4*)(O + row * 4096 + col0 + HALF) = w[1]; }
#undef EG_LOAD
    }
};

struct EpiResidLn {
    static constexpr bool PERM = false, AFTER_DRAIN = false, HAS_MID = false;
    float* Zio; const float* stats; const float* g1; const float* b1; const float* gt; int modstride; float alpha;
    __device__ __forceinline__ void operator()(const f32x4 (&acc)[2][2][4][2], const Unit& u, int wr, int wc, int fr, int fq) const {
        const int row0 = u.pm * BM + wr * 64 + fr, col0 = u.pn * BM + wc * 32 + 4 * fq;
        const float* g = gt + (size_t)((u.pm * BM) >> 13) * modstride;
#pragma unroll
        for (int bj = 0; bj < 2; ++bj) {
            f32x4 gv[2], lg[2], lb[2];
#pragma unroll
            for (int n = 0; n < 2; ++n) { const int c = col0 + bj * HALF + n * 16; gv[n] = *(const f32x4*)(g + c); lg[n] = *(const f32x4*)(g1 + c) * alpha; lb[n] = *(const f32x4*)(b1 + c) * alpha; }
            f32x4 zb[4][2]; f32x2c st[4];
#define EL_LOAD(g_) do { const int row_ = row0 + ((g_) >> 2) * HALF + ((g_) & 3) * 16; const float* zp_ = Zio + (size_t)row_ * 4096 + col0 + bj * HALF; zb[(g_) & 3][0] = *(const f32x4*)zp_; zb[(g_) & 3][1] = *(const f32x4*)(zp_ + 16); st[(g_) & 3] = *(const f32x2c*)(stats + 2 * row_); } while (0)
            EL_LOAD(0); EL_LOAD(1); EL_LOAD(2); EL_LOAD(3);
#pragma unroll
            for (int gi = 0; gi < 8; ++gi) { const int ai = gi >> 2, m = gi & 3; float* zp = Zio + (size_t)(row0 + ai * HALF + m * 16) * 4096 + col0 + bj * HALF;
                asm volatile("" : "+v"(zb[gi & 3][0]), "+v"(zb[gi & 3][1]), "+v"(st[gi & 3]) :: "memory");
                const float mean = st[gi & 3][0], rstd = st[gi & 3][1];
                f32x4 o[2];
#pragma unroll
                for (int n = 0; n < 2; ++n) o[n] = (zb[gi & 3][n] - mean) * rstd * lg[n] + lb[n] + gv[n] * acc[ai][bj][m][n];
                if (gi + 4 < 8) EL_LOAD(gi + 4);
                *(f32x4*)zp = o[0]; *(f32x4*)(zp + 16) = o[1]; }
#undef EL_LOAD
        }
    }
};
template <class Epi, class Sched, bool ALIGN_EPI = false, bool SP2 = false>
__device__ __forceinline__ void gemm_phase(PG8_LAS unsigned char* lds, const Gemm g, const Sched& S, const Epi& E) {
    const int tid = threadIdx.x, wid = __builtin_amdgcn_readfirstlane(tid >> 6), lane = tid & 63, wr = wid >> 2, wc = wid & 3, fr = lane & 15, fq = lane >> 4;
    const int K = g.K, nt = K / BK;
    unsigned voffA[2], voffB[2];
#pragma unroll
    for (int i = 0; i < 2; ++i) { int R, C; stage_rc(tid * 16 + i * 8192, R, C); const int Rb = Epi::PERM ? ((R & ~31) + perm32(R & 31)) : R;
        voffA[i] = (unsigned)(R * g.lda + C) * 2u; voffB[i] = (unsigned)(Rb * g.ldb + C) * 2u; }
    const size_t kstep = (size_t)(BK * 2);
    const size_t hstepA = (size_t)HALF * g.lda * 2, hstepB = (size_t)HALF * g.ldb * 2;
    const size_t tstepA = 2 * hstepA, tstepB = 2 * hstepB;
    const unsigned ldsw = (unsigned)wid * 1024u;
    const int aoff = lds_byte(wr * 64 + fr, fq * 8), boff = lds_byte(wc * 32 + fr, fq * 8);
#define PG8_SA(b, h) (((b) * 2 + (h)) * HTB)
#define PG8_SB(b, h) ((4 + (b) * 2 + (h)) * HTB)
#define PG8_STAGE(bufoff, gbase, voff) do { _Pragma("unroll") for (int _i = 0; _i < 2; ++_i) \
        __builtin_amdgcn_global_load_lds((const unsigned*)((const char*)(gbase) + (voff)[_i]), (PG8_LAS unsigned*)(lds + (bufoff) + ldsw + _i * 8192), 16, 0, 0); } while (0)
#define PG8_LDA(dst, b, h) do { _Pragma("unroll") for (int m = 0; m < 4; ++m) _Pragma("unroll") for (int k = 0; k < 2; ++k) dst[m][k] = *(const PG8_LAS bf16x8*)(lds + PG8_SA(b, h) + aoff + m * 2048 + k * 1024); } while (0)
#define PG8_LDB(dst, b, h) do { _Pragma("unroll") for (int n = 0; n < 2; ++n) _Pragma("unroll") for (int k = 0; k < 2; ++k) dst[n][k] = *(const PG8_LAS bf16x8*)(lds + PG8_SB(b, h) + boff + n * 2048 + k * 1024); } while (0)
#define PG8_MMA(ai, bj, At, Bt) do { __builtin_amdgcn_s_setprio(1); _Pragma("unroll") for (int m = 0; m < 4; ++m) _Pragma("unroll") for (int n = 0; n < 2; ++n) _Pragma("unroll") for (int k = 0; k < 2; ++k) \
        acc[ai][bj][m][n] = __builtin_amdgcn_mfma_f32_16x16x32_bf16(Bt[n][k], At[m][k], acc[ai][bj][m][n], 0, 0, 0); __builtin_amdgcn_s_setprio(0); } while (0)
#define PG8_WAIT_V(n) asm volatile("s_waitcnt vmcnt(" #n ")" ::: "memory")
#define PG8_WAIT_L(n) asm volatile("s_waitcnt lgkmcnt(" #n ")" ::: "memory")
#define PG8_BAR __builtin_amdgcn_s_barrier()
#define PG8_SCHED __builtin_amdgcn_sched_barrier(0)
    Unit cur, nxt; int ui = 0;
    if (!S.next(0, cur)) return;
    f32x4 acc[2][2][4][2];
#pragma unroll
    for (int a = 0; a < 2; ++a)
#pragma unroll
        for (int b = 0; b < 2; ++b)
#pragma unroll
            for (int m = 0; m < 4; ++m)
#pragma unroll
                for (int n = 0; n < 2; ++n) acc[a][b][m][n] = (f32x4){0.f, 0.f, 0.f, 0.f};
    bf16x8 At[4][2], B0[2][2], B1[2][2];
    const char* cA = (const char*)g.A + (size_t)cur.pm * tstepA; const char* cB = (const char*)g.Bt + (size_t)cur.pn * tstepB;
    S.a_ready(cur);
    if constexpr (SP2) {
        PG8_STAGE(PG8_SB(0, 0), cB, voffB); PG8_STAGE(PG8_SB(0, 1), cB + hstepB, voffB); PG8_STAGE(PG8_SA(0, 0), cA, voffA); PG8_STAGE(PG8_SA(0, 1), cA + hstepA, voffA);
        if (wr == 1) PG8_BAR;
        PG8_WAIT_V(2); PG8_BAR;
        PG8_STAGE(PG8_SB(1, 0), cB + kstep, voffB); PG8_STAGE(PG8_SA(1, 0), cA + kstep, voffA); PG8_STAGE(PG8_SB(1, 1), cB + hstepB + kstep, voffB);
        PG8_WAIT_V(6); PG8_BAR;
    } else {
        PG8_STAGE(PG8_SB(0, 0), cB, voffB); PG8_STAGE(PG8_SA(0, 0), cA, voffA); PG8_STAGE(PG8_SB(0, 1), cB + hstepB, voffB); PG8_STAGE(PG8_SA(0, 1), cA + hstepA, voffA);
        if (wr == 1) PG8_BAR;
        PG8_WAIT_V(4); PG8_BAR;
        PG8_STAGE(PG8_SB(1, 0), cB + kstep, voffB); PG8_STAGE(PG8_SA(1, 0), cA + kstep, voffA); PG8_STAGE(PG8_SB(1, 1), cB + hstepB + kstep, voffB);
        PG8_WAIT_V(6); PG8_BAR;
    }
    for (;;) {
        const bool has_next = S.next(ui + 1, nxt);
        const char* nA = has_next ? (const char*)g.A + (size_t)nxt.pm * tstepA : cA; const char* nB = has_next ? (const char*)g.Bt + (size_t)nxt.pn * tstepB : cB;
        for (int t = 0; t < nt; t += 2) {
            const bool last = (t == nt - 2);
            const char* a1 = cA + (size_t)(t + 1) * kstep;
            const char* a2 = last ? nA : cA + (size_t)(t + 2) * kstep; const char* b2 = last ? nB : cB + (size_t)(t + 2) * kstep;
            const char* a3 = a2 + kstep; const char* b3 = b2 + kstep;
            if constexpr (Epi::HAS_MID) { if (t == nt / 2) E.mid(acc, cur, wr, wc, fr, fq); }
            if (last && has_next) S.a_ready(nxt);
            if constexpr (SP2) {
            PG8_LDB(B0, 0, 0); PG8_LDB(B1, 0, 1); PG8_SCHED; PG8_LDA(At, 0, 0); PG8_STAGE(PG8_SA(1, 1), a1 + hstepA, voffA);
            PG8_WAIT_V(8); PG8_WAIT_L(0); PG8_BAR; PG8_MMA(0, 0, At, B0); PG8_MMA(0, 1, At, B1); PG8_BAR; PG8_SCHED;
            PG8_LDA(At, 0, 1); PG8_STAGE(PG8_SB(0, 0), b2, voffB); PG8_STAGE(PG8_SB(0, 1), b2 + hstepB, voffB); PG8_STAGE(PG8_SA(0, 0), a2, voffA);
            PG8_WAIT_V(8); PG8_WAIT_L(0); PG8_BAR; PG8_MMA(1, 0, At, B0); PG8_MMA(1, 1, At, B1); PG8_BAR; PG8_SCHED;
            PG8_LDB(B0, 1, 0); PG8_LDB(B1, 1, 1); PG8_SCHED; PG8_LDA(At, 1, 0); PG8_STAGE(PG8_SA(0, 1), a2 + hstepA, voffA);
            PG8_WAIT_V(8); PG8_WAIT_L(0); PG8_BAR; PG8_MMA(0, 0, At, B0); PG8_MMA(0, 1, At, B1); PG8_BAR; PG8_SCHED;
            PG8_LDA(At, 1, 1); PG8_STAGE(PG8_SB(1, 0), b3, voffB); PG8_STAGE(PG8_SB(1, 1), b3 + hstepB, voffB); PG8_STAGE(PG8_SA(1, 0), a3, voffA);
            PG8_WAIT_V(8); PG8_WAIT_L(0); PG8_BAR; PG8_MMA(1, 0, At, B0); PG8_MMA(1, 1, At, B1); PG8_BAR; PG8_SCHED;
            } else {
            PG8_LDB(B0, 0, 0); PG8_SCHED; PG8_LDA(At, 0, 0); PG8_STAGE(PG8_SA(1, 1), a1 + hstepA, voffA);
            PG8_WAIT_L(8); PG8_BAR; PG8_WAIT_L(0); PG8_MMA(0, 0, At, B0); PG8_BAR; PG8_SCHED;
            PG8_LDB(B1, 0, 1); PG8_STAGE(PG8_SB(0, 0), b2, voffB);
            PG8_BAR; PG8_WAIT_L(0); PG8_MMA(0, 1, At, B1); PG8_BAR;
            PG8_LDA(At, 0, 1); PG8_STAGE(PG8_SA(0, 0), a2, voffA);
            PG8_BAR; PG8_WAIT_L(0); PG8_MMA(1, 0, At, B0); PG8_BAR; PG8_SCHED;
            PG8_STAGE(PG8_SB(0, 1), b2 + hstepB, voffB);
            PG8_WAIT_V(6); PG8_BAR; PG8_MMA(1, 1, At, B1); PG8_BAR;
            PG8_LDB(B0, 1, 0); PG8_SCHED; PG8_LDA(At, 1, 0); PG8_STAGE(PG8_SA(0, 1), a2 + hstepA, voffA);
            PG8_WAIT_L(8); PG8_BAR; PG8_WAIT_L(0); PG8_MMA(0, 0, At, B0); PG8_BAR; PG8_SCHED;
            PG8_LDB(B1, 1, 1); PG8_STAGE(PG8_SB(1, 0), b3, voffB);
            PG8_BAR; PG8_WAIT_L(0); PG8_MMA(0, 1, At, B1); PG8_BAR;
            PG8_LDA(At, 1, 1); PG8_STAGE(PG8_SA(1, 0), a3, voffA);
            PG8_BAR; PG8_WAIT_L(0); PG8_MMA(1, 0, At, B0); PG8_BAR; PG8_SCHED;
            PG8_STAGE(PG8_SB(1, 1), b3 + hstepB, voffB);
            PG8_WAIT_V(6); PG8_BAR; PG8_MMA(1, 1, At, B1); PG8_BAR;
            }
        }
        if constexpr (ALIGN_EPI) { if (wr == 0) PG8_BAR; }
        if constexpr (!Epi::AFTER_DRAIN) { E(acc, cur, wr, wc, fr, fq); S.done(cur); }
        if (!has_next) break;
#pragma unroll
        for (int a = 0; a < 2; ++a)
#pragma unroll
            for (int b = 0; b < 2; ++b)
#pragma unroll
                for (int m = 0; m < 4; ++m)
#pragma unroll
                    for (int n = 0; n < 2; ++n) acc[a][b][m][n] = (f32x4){0.f, 0.f, 0.f, 0.f};
        cur = nxt; cA = nA; cB = nB; ++ui;
        if constexpr (ALIGN_EPI) { if (wr == 1) PG8_BAR; }
    }
    PG8_WAIT_V(0);
    if constexpr (!ALIGN_EPI) { if (wr == 0) PG8_BAR; }
    PG8_BAR;
    if constexpr (Epi::AFTER_DRAIN) { E.fused(acc, cur, wr, wc, fr, fq, lds, wid, lane); S.done(cur); }
#undef PG8_SA
#undef PG8_SB
#undef PG8_STAGE
#undef PG8_LDA
#undef PG8_LDB
#undef PG8_MMA
#undef PG8_WAIT_V
#undef PG8_WAIT_L
#undef PG8_BAR
#undef PG8_SCHED
}
}
#define XB_TMO      128
#define XB_XCNT(j)  (256  + 64 * (j))
#define XB_XSUB(j)  (1280 + 64 * (j))
#define XB_XGEN(j)  (2304 + 64 * (j))
#define XB_TOP      3328
#define XB_TOPGEN   3392
#define XCD_BAR_WORDS 3456
#define XB_SPIN_CAP (1u << 18)

__device__ __forceinline__ unsigned xb_ld(unsigned* p)              { return __hip_atomic_load(p, __ATOMIC_RELAXED, __HIP_MEMORY_SCOPE_AGENT); }
__device__ __forceinline__ unsigned xb_add(unsigned* p, unsigned v) { return __hip_atomic_fetch_add(p, v, __ATOMIC_RELAXED, __HIP_MEMORY_SCOPE_AGENT); }
__device__ __forceinline__ unsigned xb_xcc_id() { return (unsigned)__builtin_amdgcn_s_getreg((3 << 11) | 20) & 0xFu; }
#define XB_SPIN(cond, bar) do { unsigned _sp = 0; while (cond) { __builtin_amdgcn_s_sleep(1); \
    if ((++_sp & 255u) == 0u) { if (xb_ld(&(bar)[XB_TMO])) break; if (_sp > XB_SPIN_CAP) { atomicAdd(&(bar)[XB_TMO], 1u); break; } } } } while (0)

struct XcdBarrier {
    unsigned* bar; unsigned x;
    volatile LAS unsigned* st;
};

__device__ __forceinline__ XcdBarrier xcd_barrier_post(unsigned* bar, volatile LAS unsigned* st) {
    XcdBarrier b; b.bar = bar; b.x = xb_xcc_id(); b.st = st;
    if (threadIdx.x == 0) (void)xb_add(&bar[XB_XCNT(b.x)], 1u);
    return b;
}
__device__ __forceinline__ void xcd_barrier_complete(unsigned* bar, unsigned x, unsigned& nloc, unsigned& nx) {
    const unsigned G = gridDim.x * gridDim.y * gridDim.z;
    unsigned sum, cnt, mine, sp = 0u;
    for (;;) {
        sum = 0u; cnt = 0u; mine = 0u;
#pragma unroll
        for (unsigned j = 0; j < 16; ++j) { const unsigned c = xb_ld(&bar[XB_XCNT(j)]); sum += c; cnt += (c > 0u) ? 1u : 0u; mine = (j == x) ? c : mine; }
        if (sum == G) break;
        __builtin_amdgcn_s_sleep(1);
        if ((++sp & 255u) == 0u) { if (xb_ld(&bar[XB_TMO])) break; if (sp > XB_SPIN_CAP) { atomicAdd(&bar[XB_TMO], 1u); break; } }
    }
    nloc = mine > 0u ? mine : 1u; nx = cnt > 0u ? cnt : 1u;
}

__device__ __forceinline__ void xcd_barrier(const XcdBarrier& b) {
    asm volatile("s_waitcnt vmcnt(0)" ::: "memory");
    __syncthreads();
    if (threadIdx.x == 0) {
        unsigned* bar = b.bar;
        __builtin_amdgcn_s_waitcnt(0);
        unsigned nloc = b.st[0], nx = b.st[1];
        if (nloc == 0u) { xcd_barrier_complete(bar, b.x, nloc, nx); b.st[0] = nloc; b.st[1] = nx; }
        const unsigned old = xb_add(&bar[XB_XSUB(b.x)], 1u);
        const unsigned gen = old / nloc;
        if (old + 1u == (gen + 1u) * nloc) {
            __builtin_amdgcn_fence(__ATOMIC_RELEASE, "agent");
            asm volatile("s_waitcnt vmcnt(0)" ::: "memory");
            const unsigned og = xb_add(&bar[XB_TOP], 1u);
            const unsigned tg = og / nx;
            if (og + 1u == (tg + 1u) * nx) xb_add(&bar[XB_TOPGEN], 1u);
            else XB_SPIN(xb_ld(&bar[XB_TOPGEN]) == tg, bar);
            __builtin_amdgcn_fence(__ATOMIC_ACQUIRE, "agent");
            xb_add(&bar[XB_XGEN(b.x)], 1u);
            asm volatile("s_waitcnt vmcnt(0)" ::: "memory");
        } else {
            XB_SPIN(xb_ld(&bar[XB_XGEN(b.x)]) == gen, bar);
            __builtin_amdgcn_fence(__ATOMIC_ACQUIRE, "agent");
            asm volatile("s_waitcnt vmcnt(0)" ::: "memory");
        }
    }
    __syncthreads();
}
#ifndef MK_N_LAUNCHES
#define MK_N_LAUNCHES 1
#endif
constexpr int NWAVES = 8, NTHR = 512;
constexpr int D = 4096, BATCH = 2, T = 8192, LC = 256;
constexpr int M_LAT = BATCH * T, M_CTX = BATCH * LC, M_ALL = M_LAT + M_CTX;
constexpr int C = 2048, NH = 32, HS = 64;
constexpr int NRW = 6784, NRWP = 6912, NQKV = 3072, NGATE = 8192, N_IN = 18048, N_INP = NRWP + NQKV + NGATE;
constexpr int DFF = 11008;
constexpr int NMOD = 6 * D;
constexpr float LN_EPS = 1e-5f, GN_EPS = 64e-5f, ALPHA = 1.189207115002721f;
constexpr int NPHASE = 15;
#ifndef REPMASK
#define REPMASK 0
#endif

constexpr size_t MiB = 1u << 20;
constexpr size_t WS_CTL = 0, CTL_ZERO_BYTES = 64 * 1024;
constexpr size_t WS_MOD = 256 * 1024;
constexpr size_t WS_MODP = 1 * MiB;
constexpr size_t WS_WOCAT = 8 * MiB, WS_WOUT = 40 * MiB;
constexpr size_t WS_W1 = 72 * MiB;
constexpr size_t WS_H = 214 * MiB;
constexpr size_t WS_IPRW = 346 * MiB;
constexpr size_t WS_IPQKV = 569 * MiB;
constexpr size_t WS_IPGATE = 668 * MiB;
constexpr size_t WS_R = 72 * MiB, WS_K = 138 * MiB, WS_V = 204 * MiB;
constexpr size_t WS_INVN = 270 * MiB;
constexpr size_t WS_BONUS = 1 * MiB;
constexpr size_t WS_G = 273 * MiB;
constexpr size_t WS_MA = 924 * MiB;
constexpr size_t WS_ROPE = 924 * MiB;
constexpr size_t WS_ICLR = 1052 * MiB;
constexpr size_t WS_DEC = 1184 * MiB;
constexpr size_t WS_WGU = 346 * MiB;
constexpr size_t WS_WDN = 1448 * MiB;
constexpr size_t WS_TMP = 72 * MiB;
constexpr size_t WS_MERGED = 1052 * MiB;
constexpr size_t WS_X1 = 72 * MiB;
constexpr size_t WS_H2 = 1180 * MiB;
constexpr size_t WS_ACT = 668 * MiB;
constexpr size_t WS_LORAT = 5 * MiB + 512 * 1024;
constexpr size_t WS_END = 1534 * MiB;
constexpr int CW_BAR = 4096;
static_assert((CW_BAR + 3456) * 4 <= (int)CTL_ZERO_BYTES, "ctl");

constexpr int RING_OFF = 0, RING_BYTES = 131072;
constexpr int LDS_BYTES = 163840;
constexpr int LDSCTL_OFF = LDS_BYTES - 512, MISC_OFF = LDSCTL_OFF + 320;

#define GAS __attribute__((address_space(1)))
typedef unsigned short bf16;
typedef unsigned v4u __attribute__((ext_vector_type(4)));
typedef unsigned v2u __attribute__((ext_vector_type(2)));
typedef float f32x4 __attribute__((ext_vector_type(4)));
typedef float f32x2 __attribute__((ext_vector_type(2)));
typedef short bf16x8 __attribute__((ext_vector_type(8)));
typedef short bf16x4 __attribute__((ext_vector_type(4)));
typedef short s16x4 __attribute__((ext_vector_type(4)));
#define LDS_WAIT() asm volatile("s_waitcnt lgkmcnt(0)" ::: "memory")
#define VM_WAIT() asm volatile("s_waitcnt vmcnt(0)" ::: "memory")
__device__ __forceinline__ unsigned f2bf(float f) { unsigned u = __float_as_uint(f); return (u + 0x7fffu + ((u >> 16) & 1u)) >> 16; }
__device__ __forceinline__ unsigned pk2(float lo, float hi) { return pg8::cvt_pk_bf16(lo, hi); }
__device__ __forceinline__ float bf2f(bf16 v) { return __uint_as_float((unsigned)v << 16); }
__device__ __forceinline__ float bflo(unsigned w) { return __uint_as_float(w << 16); }
__device__ __forceinline__ float bfhi(unsigned w) { return __uint_as_float(w & 0xffff0000u); }
__device__ __forceinline__ float sigmf(float x) { return __builtin_amdgcn_rcpf(1.0f + __expf(-x)); }
template <int CTRL> __device__ __forceinline__ float dpp_mov(float v) { return __int_as_float(__builtin_amdgcn_update_dpp(0, __float_as_int(v), CTRL, 0xF, 0xF, true)); }
__device__ __forceinline__ float rows_sum(float v) {
    auto a = __builtin_amdgcn_permlane16_swap(__float_as_uint(v), __float_as_uint(v), false, false); v = __uint_as_float(a[0]) + __uint_as_float(a[1]);
    auto b = __builtin_amdgcn_permlane32_swap(__float_as_uint(v), __float_as_uint(v), false, false); return __uint_as_float(b[0]) + __uint_as_float(b[1]);
}
__device__ __forceinline__ float rows_max(float v) {
    auto a = __builtin_amdgcn_permlane16_swap(__float_as_uint(v), __float_as_uint(v), false, false); v = fmaxf(__uint_as_float(a[0]), __uint_as_float(a[1]));
    auto b = __builtin_amdgcn_permlane32_swap(__float_as_uint(v), __float_as_uint(v), false, false); return fmaxf(__uint_as_float(b[0]), __uint_as_float(b[1]));
}
__device__ __forceinline__ float wave_sum(float v) {
    v += dpp_mov<0xB1>(v);
    v += dpp_mov<0x4E>(v);
    v += dpp_mov<0x141>(v);
    v += dpp_mov<0x140>(v);
    const int b = __float_as_int(v);
    return (__int_as_float(__builtin_amdgcn_readlane(b, 0)) + __int_as_float(__builtin_amdgcn_readlane(b, 16))) + (__int_as_float(__builtin_amdgcn_readlane(b, 32)) + __int_as_float(__builtin_amdgcn_readlane(b, 48)));
}

struct Frame {
    LAS unsigned char* lds;
    int tid, lane, wave, G, blk;
    const float* in[29]; float* out; unsigned char* ws;
};
enum { I_X = 0, I_C, I_CTX, I_CCTX, I_WADA, I_BADA, I_WIN, I_SHIFT, I_W0, I_WUP, I_A0, I_AUP, I_GUP, I_KK, I_KA, I_RK, I_GNG, I_GNB, I_SINK, I_WRO, I_WAO, I_WOUT, I_LN1G, I_LN1B, I_WFG, I_WFU, I_WFD, I_LN2G, I_LN2B };

struct TItem { const float* src; bf16* dst; int N, ldk, rp; };
__device__ __forceinline__ void t_load(const TItem& t, f32x4 (&v)[8], int lane) {
#pragma unroll
    for (int i = 0; i < 8; ++i) v[i] = *(const f32x4*)(t.src + (size_t)(8 * i + (lane >> 3)) * t.N + 4 * (lane & 7));
}
__device__ __forceinline__ void t_store(const TItem& t, const f32x4 (&v)[8], LAS float* scr, int lane) {
#pragma unroll
    for (int i = 0; i < 8; ++i) { LAS float* p = scr + (8 * i + (lane >> 3)) * 33 + 4 * (lane & 7); p[0] = v[i][0]; p[1] = v[i][1]; p[2] = v[i][2]; p[3] = v[i][3]; }
    LDS_WAIT(); asm volatile("" ::: "memory");
    const int c = lane & 7;
#pragma unroll
    for (int j = 0; j < 4; ++j) { const int n = (lane >> 3) + 8 * j; const LAS float* s = scr + (8 * c) * 33 + n;
        v4u o; o.x = pk2(s[0 * 33], s[1 * 33]); o.y = pk2(s[2 * 33], s[3 * 33]); o.z = pk2(s[4 * 33], s[5 * 33]); o.w = pk2(s[6 * 33], s[7 * 33]);
        const int nr = t.rp ? 8 * (n >> 2) + (n & 3) : n;
        *(v4u*)(t.dst + (size_t)nr * t.ldk + 8 * c) = o; }
    LDS_WAIT(); asm volatile("" ::: "memory");
}
__device__ __forceinline__ TItem t_make(const float* W, int N, bf16* WT, size_t drow, int ldk, int koff, int k0, int n0) { TItem t; t.src = W + (size_t)k0 * N + n0; t.dst = WT + drow * (size_t)ldk + koff + k0; t.N = N; t.ldk = ldk; t.rp = 0; return t; }
#define T_PIPELINE(NITEMS_, DECODE_) do { int it_ = gw; if (it_ < (NITEMS_)) { TItem cur_ = DECODE_(it_); f32x4 v_[8]; t_load(cur_, v_, F.lane); \
        for (;;) { const int nx_ = it_ + NGW; const bool has_ = nx_ < (NITEMS_); TItem nxt_ = cur_; f32x4 vn_[8]; \
            if (has_) { nxt_ = DECODE_(nx_); t_load(nxt_, vn_, F.lane); } else { _Pragma("unroll") for (int i_ = 0; i_ < 8; ++i_) vn_[i_] = (f32x4){0.f, 0.f, 0.f, 0.f}; } \
            t_store(cur_, v_, scr, F.lane); if (!has_) break; cur_ = nxt_; it_ = nx_; _Pragma("unroll") for (int i_ = 0; i_ < 8; ++i_) v_[i_] = vn_[i_]; } } } while (0)
__device__ __forceinline__ void p0_convert_a(Frame& F) {
    LAS float* scr = (LAS float*)(F.lds + RING_OFF + F.wave * 16384);
    const int gw = F.blk * NWAVES + F.wave, NGW = F.G * NWAVES;
    bf16* W1 = (bf16*)(F.ws + WS_W1); bf16* WOC = (bf16*)(F.ws + WS_WOCAT); bf16* WOUT = (bf16*)(F.ws + WS_WOUT); bf16* LT = (bf16*)(F.ws + WS_LORAT);
    constexpr int I_IN = (D / 64) * (N_IN / 32), I_RO = (C / 64) * (D / 32), I_OUT = (D / 64) * (D / 32);
    constexpr int I_LW = 3 * (C / 32), I_LG = 4 * (C / 32);
    constexpr int NITEMS = I_IN + 2 * I_LW + I_LG;
    auto decode = [&](int it) -> TItem {
        int r = it;
        if (r < I_IN) { const int nb = r % (N_IN / 32), kb = r / (N_IN / 32), n0 = 32 * nb;
            if (n0 >= NRW && n0 < NRW + 2560) {
                const int hd = (n0 - NRW) >> 7, d0 = (n0 - NRW) & 127; TItem t = t_make(F.in[I_WIN], N_IN, W1, (size_t)(NRWP + hd * 128 + 8 * ((d0 & 63) >> 2) + (d0 >= 64 ? 4 : 0)), D, 0, 64 * kb, n0); t.rp = 1; return t; }
            return t_make(F.in[I_WIN], N_IN, W1, (size_t)(n0 + (n0 >= NRW ? NRWP - NRW : 0)), D, 0, 64 * kb, n0); } r -= I_IN;
        if (r < I_LW) { const int nb = r % (C / 32), kb = r / (C / 32); return t_make(F.in[I_WUP], C, LT, (size_t)(32 * nb), 640, 0, 64 * kb, 32 * nb); } r -= I_LW;
        if (r < I_LW) { const int nb = r % (C / 32), kb = r / (C / 32); return t_make(F.in[I_AUP], C, LT, (size_t)(32 * nb), 640, 192, 64 * kb, 32 * nb); } r -= I_LW;
        { const int nb = r % (C / 32), kb = r / (C / 32); return t_make(F.in[I_GUP], C, LT, (size_t)(32 * nb), 640, 384, 64 * kb, 32 * nb); }
    };
    T_PIPELINE(NITEMS, decode);
    { float* RC = (float*)(F.ws + WS_ROPE); float* RS = RC + T * 64;
      for (int i = F.blk * NTHR + F.tid; i < T * 64; i += F.G * NTHR) { const int t = i >> 6, p = i & 63;
          const float inv = exp2f(-(float)(p & 31) * (13.287712379549449f / 32.0f)), ang = (p < 32 ? (float)(t >> 6) : (float)(t & 63)) * inv; RC[i] = cosf(ang); RS[i] = sinf(ang); } }
    { v4u z = {0u, 0u, 0u, 0u}; v4u* p = (v4u*)(W1 + (size_t)NRW * D); const int n16 = (NRWP - NRW) * D / 8;
      for (int i = F.blk * NTHR + F.tid; i < n16; i += F.G * NTHR) p[i] = z; }
    float* MODP = (float*)(F.ws + WS_MODP);
    const float* wada = F.in[I_WADA];
    for (int task = gw; task < 96 * 16; task += NGW) {
        const int cg = task % 96, ks = task / 96, col = cg * 256 + F.lane * 4;
        f32x4 a0 = {0.f, 0.f, 0.f, 0.f}, a1 = a0, a2 = a0;
        const float* c0 = F.in[I_C] + ks * 256; const float* c1 = F.in[I_C] + D + ks * 256; const float* c2 = F.in[I_CCTX] + ks * 256;
#pragma unroll 4
        for (int k = 0; k < 256; ++k) {
            const f32x4 w = *(const f32x4*)(wada + (size_t)(ks * 256 + k) * NMOD + col);
            const float x0 = c0[k], x1 = c1[k], x2 = c2[k];
            a0 += w * (x0 * sigmf(x0)); a1 += w * (x1 * sigmf(x1)); a2 += w * (x2 * sigmf(x2));
        }
        float* o = MODP + (size_t)ks * 3 * NMOD + col;
        *(f32x4*)o = a0; *(f32x4*)(o + NMOD) = a1; *(f32x4*)(o + 2 * NMOD) = a2;
    }
}
constexpr int FFN_ID0 = 86 * (D / 32);
__device__ __forceinline__ void p_convert_ffn(Frame& F, int wg0, int nwg, int part) {
    LAS float* scr = (LAS float*)(F.lds + RING_OFF + F.wave * 16384);
    const int gw = (F.blk - wg0) * NWAVES + F.wave, NGW = nwg * NWAVES;
    bf16* WGU = (bf16*)(F.ws + WS_WGU); bf16* WDN = (bf16*)(F.ws + WS_WDN);
    constexpr int I_G = (D / 64) * (DFF / 32), I_D = (DFF / 64) * (D / 32);
    constexpr int I_OUT = (D / 64) * (D / 32), I_RO = (C / 64) * (D / 32); bf16* WOUT = (bf16*)(F.ws + WS_WOUT); bf16* WOC = (bf16*)(F.ws + WS_WOCAT);
    const int NITEMS = part == 0 ? 2 * I_RO + I_OUT + 2 * I_G + FFN_ID0 : I_D - FFN_ID0;
    auto decode = [&](int it) -> TItem {
        int r = part == 0 ? it : it + 2 * I_RO + I_OUT + 2 * I_G + FFN_ID0;
        if (r < I_RO) { const int nb = r % (D / 32), kb = r / (D / 32); return t_make(F.in[I_WRO], D, WOC, (size_t)(32 * nb), D, 0, 64 * kb, 32 * nb); } r -= I_RO;
        if (r < I_RO) { const int nb = r % (D / 32), kb = r / (D / 32); return t_make(F.in[I_WAO], D, WOC, (size_t)(32 * nb), D, C, 64 * kb, 32 * nb); } r -= I_RO;
        if (r < I_OUT) { const int nb = r % (D / 32), kb = r / (D / 32); return t_make(F.in[I_WOUT], D, WOUT, (size_t)(32 * nb), D, 0, 64 * kb, 32 * nb); } r -= I_OUT;
        if (r < I_G) { const int nb = r % (DFF / 32), kb = r / (DFF / 32), n0 = 32 * nb; return t_make(F.in[I_WFG], DFF, WGU, (size_t)((n0 >> 7) * 256 + (n0 & 127)), D, 0, 64 * kb, n0); } r -= I_G;
        if (r < I_G) { const int nb = r % (DFF / 32), kb = r / (DFF / 32), n0 = 32 * nb; return t_make(F.in[I_WFU], DFF, WGU, (size_t)((n0 >> 7) * 256 + 128 + (n0 & 127)), D, 0, 64 * kb, n0); } r -= I_G;
        { const int nb = r % (D / 32), kb = r / (D / 32); return t_make(F.in[I_WFD], D, WDN, (size_t)(32 * nb), DFF, 0, 64 * kb, 32 * nb); }
    };
    T_PIPELINE(NITEMS, decode);
}
__device__ __forceinline__ void p1_mod(Frame& F) {
    const float* MODP = (const float*)(F.ws + WS_MODP); float* MOD = (float*)(F.ws + WS_MOD); const float* bada = F.in[I_BADA];
    for (int i = F.blk * NTHR + F.tid; i < 3 * NMOD; i += F.G * NTHR) {
        float s = bada[i % NMOD];
#pragma unroll
        for (int ks = 0; ks < 16; ++ks) s += MODP[(size_t)ks * 3 * NMOD + i];
        MOD[i] = s;
    }
}
__device__ __forceinline__ void p2_modulate(Frame& F) {
    const int gw = F.blk * NWAVES + F.wave, NGW = F.G * NWAVES;
    const float* MOD = (const float*)(F.ws + WS_MOD); bf16* H = (bf16*)(F.ws + WS_H);
    for (int m = gw; m < M_ALL; m += NGW) {
        const int b = m < M_LAT ? (m >> 13) : 2;
        const float* src = m < M_LAT ? F.in[I_X] + (size_t)m * D : F.in[I_CTX] + (size_t)(m - M_LAT) * D;
        const float* sh = MOD + (size_t)b * NMOD; const float* sc = sh + D;
        v2u* o = (v2u*)(H + (size_t)m * D);
#pragma unroll 8
        for (int j = 0; j < 16; ++j) { const int c = 4 * F.lane + 256 * j;
            const f32x4 v = *(const f32x4*)(src + c), s = *(const f32x4*)(sc + c), h = *(const f32x4*)(sh + c);
            const f32x4 r = v * (s + 1.0f) + h; v2u w; w.x = pk2(r[0], r[1]); w.y = pk2(r[2], r[3]); o[F.lane + 64 * j] = w; }
    }
}

constexpr int ACT_PITCH = 648;
constexpr int FTOK = 32;
template <int PART> __device__ __forceinline__ void p4_features_mfma(Frame& F, const int wg0, const int nwg) {
    LAS bf16* act = (LAS bf16*)(F.lds + RING_OFF);
    const bf16* IPRW = (const bf16*)(F.ws + WS_IPRW);
    const float* shw = F.in[I_SHIFT];
    bf16* Rb = (bf16*)(F.ws + WS_R); bf16* Kb = (bf16*)(F.ws + WS_K); bf16* Vb = (bf16*)(F.ws + WS_V);
    bf16* ICL = (bf16*)(F.ws + WS_ICLR); bf16* DEC = (bf16*)(F.ws + WS_DEC); float* INVN = (float*)(F.ws + WS_INVN); bf16* Gb = (bf16*)(F.ws + WS_G);
    const bf16* LT = (const bf16*)(F.ws + WS_LORAT); float* BON = (float*)(F.ws + WS_BONUS);
    constexpr int NITEM = ((PART ? M_LAT : M_ALL) / FTOK) * 4;
    const int i0 = (int)(((long)(F.blk - wg0) * NITEM) / nwg), i1 = (int)(((long)(F.blk - wg0 + 1) * NITEM) / nwg);
    for (int item = i0; item < i1; ++item) {
        int lane_o = F.lane; asm volatile("" : "+v"(lane_o)); const int lane = lane_o, l16 = lane & 15, gq = lane >> 4;
        const int tile = item >> 2, q = item & 3, m0 = tile * FTOK, head = q * 8 + F.wave, chb = head * 64;
        int s0, s1;
        if (m0 < M_LAT) { s0 = (m0 >> 13) << 13; s1 = s0 + T; } else { s0 = M_LAT + (((m0 - M_LAT) >> 8) << 8); s1 = s0 + LC; }
        if (item == i0 || q == 0) {
            __syncthreads();
#pragma unroll 1
            for (int cj = (PART ? 384 : 0) + F.tid; cj < (PART ? 640 : 384); cj += NTHR) {
                const int c = 6144 + cj; const float sa = shw[c], sb = shw[NRW + c], sc = shw[2 * NRW + c];
                float xr[FTOK + 2];
#pragma unroll
                for (int i = 0; i < FTOK + 2; ++i) { const int mm = m0 - 1 + i; xr[i] = (mm >= s0 && mm < s1) ? bf2f(IPRW[(size_t)mm * NRWP + c]) : 0.f; }
#pragma unroll
                for (int tt = 0; tt < FTOK; ++tt) { float v = xr[tt] * sa + xr[tt + 1] * sb + xr[tt + 2] * sc;
                    if (cj < 192) v = 1.0f - 2.0f * __builtin_amdgcn_rcpf(1.0f + __expf(2.0f * v)); else if (cj >= 384) v = sigmf(v);
                    act[tt * ACT_PITCH + cj] = (bf16)f2bf(v); }
            }
            __syncthreads();
        }
        const bf16* wrow = LT + (size_t)(chb + 16 * (l16 >> 2) + (l16 & 3)) * 640 + 8 * gq;
        const LAS bf16* arow = act + l16 * ACT_PITCH + 8 * gq;
        const int cl = chb + 16 * gq;
        const bool lat = m0 < M_LAT;
        bf16x8 wcur[4][4], wnxt[4][4];
#pragma unroll
        for (int ks = 0; ks < 4; ++ks)
#pragma unroll
            for (int nt = 0; nt < 4; ++nt) { wcur[ks][nt] = (bf16x8){0, 0, 0, 0, 0, 0, 0, 0}; wnxt[ks][nt] = wcur[ks][nt]; }
#pragma unroll
        for (int ks = 0; ks < (PART ? 4 : 3); ++ks)
#pragma unroll
            for (int nt = 0; nt < 4; ++nt) wcur[ks][nt] = *(const bf16x8*)(wrow + (size_t)nt * 4 * 640 + (PART ? 384 : 0) + ks * 32);
        f32x4 acc[2][4];
#pragma unroll
        for (int s = (PART ? 4 : 0); s < (PART ? 6 : 4); ++s) {
            const int k0 = s < 4 ? s * 96 : 384 + (s - 4) * 128, nks = s < 4 ? 3 : 4;
            if (s + 1 < (PART ? 6 : 4)) { const int k1 = (s + 1) < 4 ? (s + 1) * 96 : 384 + (s + 1 - 4) * 128, nk1 = (s + 1) < 4 ? 3 : 4;
#pragma unroll
                for (int ks = 0; ks < 4; ++ks) if (ks < nk1) {
#pragma unroll
                    for (int nt = 0; nt < 4; ++nt) wnxt[ks][nt] = *(const bf16x8*)(wrow + (size_t)nt * 4 * 640 + k1 + ks * 32); } }
            if (s < 4 || lat) {
                if (s != 5) {
#pragma unroll
                    for (int tt = 0; tt < 2; ++tt)
#pragma unroll
                        for (int nt = 0; nt < 4; ++nt) acc[tt][nt] = (f32x4){0.f, 0.f, 0.f, 0.f}; }
#pragma unroll
                for (int ks = 0; ks < 4; ++ks) if (ks < nks) { const int k = k0 + ks * 32;
                    const bf16x8 af0 = *(const LAS bf16x8*)(arow + k), af1 = *(const LAS bf16x8*)(arow + 16 * ACT_PITCH + k);
#pragma unroll
                    for (int nt = 0; nt < 4; ++nt) { acc[0][nt] = __builtin_amdgcn_mfma_f32_16x16x32_bf16(wcur[ks][nt], af0, acc[0][nt], 0, 0, 0); acc[1][nt] = __builtin_amdgcn_mfma_f32_16x16x32_bf16(wcur[ks][nt], af1, acc[1][nt], 0, 0, 0); } }
                if (s < 4) {
                    const float* bias = (s < 2 ? F.in[I_W0] : F.in[I_A0]) + (s & 1) * C + cl;
                    f32x4 bv[4];
#pragma unroll
                    for (int nt = 0; nt < 4; ++nt) bv[nt] = *(const f32x4*)(bias + 4 * nt);
#pragma unroll
                    for (int tt = 0; tt < 2; ++tt) { const size_t o = (size_t)(m0 + tt * 16 + l16) * C + cl; f32x4 sg[4];
#pragma unroll
                        for (int nt = 0; nt < 4; ++nt) { const f32x4 z = acc[tt][nt] + bv[nt];
#pragma unroll
                            for (int e = 0; e < 4; ++e) sg[nt][e] = sigmf(z[e]); }
                        if (s < 2) { v4u w0, w1; const float ce = 0.6065306597126334f;
                            w0.x = pk2(ce * sg[0][0], ce * sg[0][1]); w0.y = pk2(ce * sg[0][2], ce * sg[0][3]); w0.z = pk2(ce * sg[1][0], ce * sg[1][1]); w0.w = pk2(ce * sg[1][2], ce * sg[1][3]);
                            w1.x = pk2(ce * sg[2][0], ce * sg[2][1]); w1.y = pk2(ce * sg[2][2], ce * sg[2][3]); w1.z = pk2(ce * sg[3][0], ce * sg[3][1]); w1.w = pk2(ce * sg[3][2], ce * sg[3][3]);
                            bf16* p = DEC + (size_t)s * M_ALL * C + o; *(v4u*)p = w0; *(v4u*)(p + 8) = w1; }
                        else { v4u w0, w1; w0.x = pk2(sg[0][0], sg[0][1]); w0.y = pk2(sg[0][2], sg[0][3]); w0.z = pk2(sg[1][0], sg[1][1]); w0.w = pk2(sg[1][2], sg[1][3]);
                            w1.x = pk2(sg[2][0], sg[2][1]); w1.y = pk2(sg[2][2], sg[2][3]); w1.z = pk2(sg[3][0], sg[3][1]); w1.w = pk2(sg[3][2], sg[3][3]);
                            bf16* p = ICL + (size_t)(s - 2) * M_ALL * C + o; *(v4u*)p = w0; *(v4u*)(p + 8) = w1; } }
                } else if (s == 5) {
#pragma unroll
                    for (int tt = 0; tt < 2; ++tt) { const size_t o = (size_t)(m0 + tt * 16 + l16) * C + cl; v4u w0, w1;
                        w0.x = pk2(acc[tt][0][0], acc[tt][0][1]); w0.y = pk2(acc[tt][0][2], acc[tt][0][3]); w0.z = pk2(acc[tt][1][0], acc[tt][1][1]); w0.w = pk2(acc[tt][1][2], acc[tt][1][3]);
                        w1.x = pk2(acc[tt][2][0], acc[tt][2][1]); w1.y = pk2(acc[tt][2][2], acc[tt][2][3]); w1.z = pk2(acc[tt][3][0], acc[tt][3][1]); w1.w = pk2(acc[tt][3][2], acc[tt][3][3]);
                        *(v4u*)(Gb + o) = w0; *(v4u*)(Gb + o + 8) = w1; }
                }
            }
#pragma unroll
            for (int ks = 0; ks < 4; ++ks)
#pragma unroll
                for (int nt = 0; nt < 4; ++nt) wcur[ks][nt] = wnxt[ks][nt];
        }
#pragma unroll 1
        for (int tt = 0; tt < (PART ? 0 : 2); ++tt) {
            const int m = m0 + tt * 16 + l16; const bool hm = (m - 1 >= s0), hp = (m + 1 < s1);
            const size_t o = (size_t)m * C + cl; const bf16* p0 = IPRW + (size_t)m * NRWP + cl;
            float nrm = 0.f, bon = 0.f; f32x4 rk4[4];
#pragma unroll
            for (int x = 0; x < 3; ++x) {
                v4u outw[2];
#pragma unroll
                for (int hf = 0; hf < 2; ++hf) {
                    const v4u w0 = *(const v4u*)(p0 + x * C + 8 * hf), wm = hm ? *(const v4u*)(p0 + x * C - NRWP + 8 * hf) : (v4u){0u, 0u, 0u, 0u}, wp = hp ? *(const v4u*)(p0 + x * C + NRWP + 8 * hf) : (v4u){0u, 0u, 0u, 0u};
                    const int cc = x * C + cl + 8 * hf;
                    const f32x4 sa0 = *(const f32x4*)(shw + cc), sa1 = *(const f32x4*)(shw + cc + 4), sb0 = *(const f32x4*)(shw + NRW + cc), sb1 = *(const f32x4*)(shw + NRW + cc + 4), sc0 = *(const f32x4*)(shw + 2 * NRW + cc), sc1 = *(const f32x4*)(shw + 2 * NRW + cc + 4);
                    const f32x4 xm0 = {bflo(wm.x), bfhi(wm.x), bflo(wm.y), bfhi(wm.y)}, xm1 = {bflo(wm.z), bfhi(wm.z), bflo(wm.w), bfhi(wm.w)};
                    const f32x4 x00 = {bflo(w0.x), bfhi(w0.x), bflo(w0.y), bfhi(w0.y)}, x01 = {bflo(w0.z), bfhi(w0.z), bflo(w0.w), bfhi(w0.w)};
                    const f32x4 xp0 = {bflo(wp.x), bfhi(wp.x), bflo(wp.y), bfhi(wp.y)}, xp1 = {bflo(wp.z), bfhi(wp.z), bflo(wp.w), bfhi(wp.w)};
                    const f32x4 v0 = xm0 * sa0 + x00 * sb0 + xp0 * sc0, v1 = xm1 * sa1 + x01 * sb1 + xp1 * sc1;
                    outw[hf].x = pk2(v0[0], v0[1]); outw[hf].y = pk2(v0[2], v0[3]); outw[hf].z = pk2(v1[0], v1[1]); outw[hf].w = pk2(v1[2], v1[3]);
                    if (x == 0) { rk4[2 * hf] = v0; rk4[2 * hf + 1] = v1; }
                    if (x == 1) { rk4[2 * hf] = rk4[2 * hf] * v0 * *(const f32x4*)(F.in[I_RK] + cl + 8 * hf); rk4[2 * hf + 1] = rk4[2 * hf + 1] * v1 * *(const f32x4*)(F.in[I_RK] + cl + 8 * hf + 4); }
                    if (x == 1) { const f32x4 q0 = v0 * *(const f32x4*)(F.in[I_KK] + cl + 8 * hf), q1 = v1 * *(const f32x4*)(F.in[I_KK] + cl + 8 * hf + 4);
                        nrm += (q0[0] * q0[0] + q0[1] * q0[1]) + (q0[2] * q0[2] + q0[3] * q0[3]) + (q1[0] * q1[0] + q1[1] * q1[1]) + (q1[2] * q1[2] + q1[3] * q1[3]); }
                }
                bf16* dst = (x == 0 ? Rb : x == 1 ? Kb : Vb) + o; *(v4u*)dst = outw[0]; *(v4u*)(dst + 8) = outw[1];
            }
            {
                if (lat) {
                    const bf16* ia = ICL + o; const bf16* ib = ICL + (size_t)M_ALL * C + o;
#pragma unroll
                    for (int hf = 0; hf < 2; ++hf) { const v4u a = *(const v4u*)(ia + 8 * hf), b = *(const v4u*)(ib + 8 * hf);
                        const f32x4 ka0 = *(const f32x4*)(F.in[I_KA] + cl + 8 * hf), ka1 = *(const f32x4*)(F.in[I_KA] + cl + 8 * hf + 4);
                        const f32x4 s0 = {bflo(a.x) + bflo(b.x), bfhi(a.x) + bfhi(b.x), bflo(a.y) + bflo(b.y), bfhi(a.y) + bfhi(b.y)}, s1 = {bflo(a.z) + bflo(b.z), bfhi(a.z) + bfhi(b.z), bflo(a.w) + bflo(b.w), bfhi(a.w) + bfhi(b.w)};
                        const f32x4 t0 = rk4[2 * hf] * ((s0 - 2.0f) * ka0 + 2.0f), t1 = rk4[2 * hf + 1] * ((s1 - 2.0f) * ka1 + 2.0f);
                        bon += (t0[0] + t0[1]) + (t0[2] + t0[3]) + (t1[0] + t1[1]) + (t1[2] + t1[3]); }
                }
            }
            nrm = rows_sum(nrm); bon = rows_sum(bon);
            if (gq == 0) { INVN[(size_t)m * NH + head] = 1.0f / fmaxf(sqrtf(nrm), 1e-12f); if (lat) BON[(size_t)m * NH + head] = bon; }
        }
    }
}
__device__ __forceinline__ void p4_rope(Frame& F) {
    const int gw = F.blk * NWAVES + F.wave, NGW = F.G * NWAVES;
    bf16* QKV = (bf16*)(F.ws + WS_IPQKV);
    const int i0 = 4 * (F.lane & 15), hq = F.lane >> 4;
    float inv[4];
#pragma unroll
    for (int e = 0; e < 4; ++e) inv[e] = exp2f(-(float)((i0 + e) & 31) * (13.287712379549449f / 32.0f));
    for (int m = gw; m < M_LAT; m += NGW) {
        const int t = m & (T - 1); const float pos = (i0 < 32) ? (float)(t >> 6) : (float)(t & 63);
        float cs[4], sn[4];
#pragma unroll
        for (int e = 0; e < 4; ++e) { const float ang = pos * inv[e]; sn[e] = sinf(ang); cs[e] = cosf(ang); }
        bf16* row = QKV + (size_t)m * NQKV + i0;
        v2u a[5], bq[5];
#pragma unroll
        for (int j = 0; j < 5; ++j) { a[j] = *(const v2u*)(row + (hq + 4 * j) * 128); bq[j] = *(const v2u*)(row + (hq + 4 * j) * 128 + 64); }
#pragma unroll
        for (int j = 0; j < 5; ++j) {
            const float x1[4] = {bflo(a[j].x), bfhi(a[j].x), bflo(a[j].y), bfhi(a[j].y)}, x2[4] = {bflo(bq[j].x), bfhi(bq[j].x), bflo(bq[j].y), bfhi(bq[j].y)};
            v2u o1, o2; o1.x = pk2(x1[0] * cs[0] - x2[0] * sn[0], x1[1] * cs[1] - x2[1] * sn[1]); o1.y = pk2(x1[2] * cs[2] - x2[2] * sn[2], x1[3] * cs[3] - x2[3] * sn[3]);
            o2.x = pk2(x2[0] * cs[0] + x1[0] * sn[0], x2[1] * cs[1] + x1[1] * sn[1]); o2.y = pk2(x2[2] * cs[2] + x1[2] * sn[2], x2[3] * cs[3] + x1[3] * sn[3]);
            *(v2u*)(row + (hq + 4 * j) * 128) = o1; *(v2u*)(row + (hq + 4 * j) * 128 + 64) = o2; }
    }
}

__device__ __forceinline__ int scan_row(int s, int d, int b) {
    if (s < LC) { const int l = d ? (LC - 1 - s) : s; return M_LAT + b * LC + l; }
    const int t = d ? (T - 1 - (s - LC)) : (s - LC); return b * T + t;
}
constexpr int SL_KT = 0, SL_RT = 2048, SL_T = 4096, SL_KK = 4608, SL_KR = 5120, SL_BR = 5632, SL_A2 = 6144, SL_V = 10240, SL_GC = 12288, SLOT_BYTES = 12544;
constexpr int NPREP = 6, NSEQ = 2;
constexpr int PRIV_OFF = NPREP * SLOT_BYTES, PRIV_BYTES = 13376, PV_INVN = 12288, PV_COEF = 12352;
static_assert(PRIV_OFF + NPREP * PRIV_BYTES <= LDSCTL_OFF, "scan LDS");
constexpr int NCHUNK = (LC + T) / 16, NROUND = NCHUNK / NPREP;
static_assert(NROUND * NPREP == NCHUNK && NPREP + NSEQ == NWAVES && NSEQ == 2 && NPREP == 6, "scan roles");

__device__ __forceinline__ void p5_scan(Frame& F) {
    const int sid = F.blk, b = sid >> 6, h = (sid >> 1) & 31, d = sid & 1, lane = F.lane, l16 = lane & 15, gq = lane >> 4;
    const bool is_prep = F.wave >= NSEQ; const int pw = is_prep ? F.wave - NSEQ : 0;
    LAS unsigned char* slots = F.lds + RING_OFF;
    LAS unsigned char* priv = F.lds + RING_OFF + PRIV_OFF + pw * PRIV_BYTES;
    const bf16* Rb = (const bf16*)(F.ws + WS_R); const bf16* Kb = (const bf16*)(F.ws + WS_K); const bf16* Vb = (const bf16*)(F.ws + WS_V);
    const bf16* ICL = (const bf16*)(F.ws + WS_ICLR) + (size_t)d * M_ALL * C; const bf16* DEC = (const bf16*)(F.ws + WS_DEC) + (size_t)d * M_ALL * C;
    const float* INVN = (const float*)(F.ws + WS_INVN);
    bf16* Y = (bf16*)F.out + (size_t)d * M_LAT * C;
    const int ch = h * HS + lane;
    const float kkc = F.in[I_KK][ch], kac = F.in[I_KA][ch];
    v2u pr[5][4]; float pinv = 0.f;
#pragma unroll
    for (int x = 0; x < 5; ++x)
#pragma unroll
        for (int i = 0; i < 4; ++i) pr[x][i] = (v2u){0u, 0u};
#define SCAN_LOAD(c_) do { _Pragma("unroll") for (int i_ = 0; i_ < 4; ++i_) { \
        const int m_ = scan_row((c_) * 16 + 4 * i_ + gq, d, b); const size_t o_ = (size_t)m_ * C + h * HS + 4 * l16; \
        pr[0][i_] = *(const v2u*)(Rb + o_); pr[1][i_] = *(const v2u*)(Kb + o_); pr[2][i_] = *(const v2u*)(Vb + o_); pr[3][i_] = *(const v2u*)(ICL + o_); pr[4][i_] = *(const v2u*)(DEC + o_); } \
        pinv = INVN[(size_t)scan_row((c_) * 16 + l16, d, b) * NH + h]; } while (0)
    if (is_prep) SCAN_LOAD(pw);
    f32x4 Sacc[4][2];
#pragma unroll
    for (int mt = 0; mt < 4; ++mt) { Sacc[mt][0] = (f32x4){0.f, 0.f, 0.f, 0.f}; Sacc[mt][1] = (f32x4){0.f, 0.f, 0.f, 0.f}; }
    float Tcol[16]; f32x4 gKK = {0.f, 0.f, 0.f, 0.f}, gKR = gKK, gBR = gKK;
#pragma unroll
    for (int t = 0; t < 16; ++t) Tcol[t] = 0.f;

#define SC_TKF(base_, kp_) ({ const int tro_ = (l16 >> 2) * 32 + (l16 & 3) * 8; \
        const s16x4 lo_ = __builtin_amdgcn_ds_read_tr16_b64_v4i16((LAS s16x4*)(sl_ + (base_) + (32 * (kp_) + 4 * gq) * 32 + tro_)), hi_ = __builtin_amdgcn_ds_read_tr16_b64_v4i16((LAS s16x4*)(sl_ + (base_) + (32 * (kp_) + 16 + 4 * gq) * 32 + tro_)); \
        (bf16x8){lo_[0], lo_[1], lo_[2], lo_[3], hi_[0], hi_[1], hi_[2], hi_[3]}; })
#define SC_PERM2(base_) (*(const LAS v2u*)(sl_ + (base_) + l16 * 32 + gq * 8))
#define SC_PF(x_) __builtin_bit_cast(bf16x8, (v4u){(x_).x, (x_).y, 0u, 0u})
    struct ScEarly { bf16x8 kt0, kt1, rt0, rt1; v2u pkk, pkr, ptt, pbr, vb[2]; };
#define SC_LOAD_EARLY(E_, slot_) do { const LAS unsigned char* sl_ = slots + (slot_) * SLOT_BYTES; int lo_ = F.lane; asm volatile("" : "+v"(lo_)); const int l16 = lo_ & 15, gq = lo_ >> 4; \
        (E_).kt0 = SC_TKF(SL_KT, 0); (E_).kt1 = SC_TKF(SL_KT, 1); (E_).rt0 = SC_TKF(SL_RT, 0); (E_).rt1 = SC_TKF(SL_RT, 1); \
        (E_).pkk = SC_PERM2(SL_KK); (E_).pkr = SC_PERM2(SL_KR); (E_).ptt = SC_PERM2(SL_T); (E_).pbr = SC_PERM2(SL_BR); \
        (E_).vb[0] = *(const LAS v2u*)(sl_ + SL_V + (32 * F.wave + l16) * 32 + gq * 8); (E_).vb[1] = *(const LAS v2u*)(sl_ + SL_V + (32 * F.wave + 16 + l16) * 32 + gq * 8); } while (0)
#define SCAN_CONSUME(c_, slot_, E_) do { \
        const LAS unsigned char* sl_ = slots + (slot_) * SLOT_BYTES; const int wv_ = F.wave; int lo_ = F.lane; asm volatile("" : "+v"(lo_)); const int l16 = lo_ & 15, gq = lo_ >> 4; \
        const f32x4 z4_ = {0.f, 0.f, 0.f, 0.f}; \
        bf16x8 Af_[4]; f32x4 gc_[4]; \
        _Pragma("unroll") for (int mt = 0; mt < 4; ++mt) { Af_[mt] = *(const LAS bf16x8*)(sl_ + SL_A2 + (16 * mt + l16) * 64 + gq * 16); gc_[mt] = *(const LAS f32x4*)(sl_ + SL_GC + (16 * mt + 4 * gq) * 4); } \
        const bf16x8 pkk_ = SC_PF((E_).pkk), pkr_ = SC_PF((E_).pkr), ptt_ = SC_PF((E_).ptt), pbr_ = SC_PF((E_).pbr); \
        bf16x8 Bf_[2]; \
        _Pragma("unroll") for (int nt = 0; nt < 2; ++nt) { \
            bf16x8 Sb_[2]; \
            _Pragma("unroll") for (int kp = 0; kp < 2; ++kp) { v4u w_; w_.x = pk2(Sacc[2 * kp][nt][0], Sacc[2 * kp][nt][1]); w_.y = pk2(Sacc[2 * kp][nt][2], Sacc[2 * kp][nt][3]); \
                w_.z = pk2(Sacc[2 * kp + 1][nt][0], Sacc[2 * kp + 1][nt][1]); w_.w = pk2(Sacc[2 * kp + 1][nt][2], Sacc[2 * kp + 1][nt][3]); Sb_[kp] = __builtin_bit_cast(bf16x8, w_); } \
            const int vcol_ = 32 * wv_ + 16 * nt + l16; \
            const v2u vb_ = (E_).vb[nt]; \
            const bf16x8 Vb8_ = __builtin_bit_cast(bf16x8, (v4u){vb_.x, vb_.y, vb_.x, vb_.y}); \
            f32x4 Ut_ = __builtin_amdgcn_mfma_f32_16x16x32_bf16(pkk_, Vb8_, z4_, 0, 0, 0); \
            Ut_ = __builtin_amdgcn_mfma_f32_16x16x32_bf16((E_).kt0, Sb_[0], Ut_, 0, 0, 0); \
            Ut_ = __builtin_amdgcn_mfma_f32_16x16x32_bf16((E_).kt1, Sb_[1], Ut_, 0, 0, 0); \
            f32x4 Ya_ = __builtin_amdgcn_mfma_f32_16x16x32_bf16(pkr_, Vb8_, z4_, 0, 0, 0); \
            Ya_ = __builtin_amdgcn_mfma_f32_16x16x32_bf16((E_).rt0, Sb_[0], Ya_, 0, 0, 0); \
            Ya_ = __builtin_amdgcn_mfma_f32_16x16x32_bf16((E_).rt1, Sb_[1], Ya_, 0, 0, 0); \
            const unsigned ut0_ = pk2(Ut_[0], Ut_[1]), ut1_ = pk2(Ut_[2], Ut_[3]); \
            const f32x4 U_ = __builtin_amdgcn_mfma_f32_16x16x32_bf16(ptt_, __builtin_bit_cast(bf16x8, (v4u){ut0_, ut1_, ut0_, ut1_}), z4_, 0, 0, 0); \
            const unsigned u0_ = pk2(U_[0], U_[1]), u1_ = pk2(U_[2], U_[3]); \
            Ya_ = __builtin_amdgcn_mfma_f32_16x16x32_bf16(pbr_, __builtin_bit_cast(bf16x8, (v4u){u0_, u1_, u0_, u1_}), Ya_, 0, 0, 0); \
            if ((c_) >= LC / 16) { const int R_ = b * T + (d ? (T - 16 - ((c_) * 16 - LC)) : ((c_) * 16 - LC));     \
                const int grp_ = (R_ >> 2) + (d ? 3 - gq : gq); const f32x4 yv_ = d ? (f32x4){Ya_[3], Ya_[2], Ya_[1], Ya_[0]} : Ya_; \
                v2u yw_; yw_.x = pk2(yv_[0], yv_[1]); yw_.y = pk2(yv_[2], yv_[3]); *(v2u*)(Y + ((size_t)grp_ * C + h * HS + vcol_) * 4) = yw_; } \
            Bf_[nt] = __builtin_bit_cast(bf16x8, (v4u){vb_.x, vb_.y, u0_, u1_}); } \
        _Pragma("unroll") for (int mt = 0; mt < 4; ++mt) { \
            Sacc[mt][0] = __builtin_amdgcn_mfma_f32_16x16x32_bf16(Af_[mt], Bf_[0], Sacc[mt][0] * gc_[mt], 0, 0, 0); \
            Sacc[mt][1] = __builtin_amdgcn_mfma_f32_16x16x32_bf16(Af_[mt], Bf_[1], Sacc[mt][1] * gc_[mt], 0, 0, 0); } \
    } while (0)
#define SCAN_CONSUME_ROUND(c0_) do { ScEarly ea_, eb_; SC_LOAD_EARLY(ea_, 0); \
        SC_LOAD_EARLY(eb_, 1); SCAN_CONSUME((c0_) + 0, 0, ea_); SC_LOAD_EARLY(ea_, 2); SCAN_CONSUME((c0_) + 1, 1, eb_); SC_LOAD_EARLY(eb_, 3); SCAN_CONSUME((c0_) + 2, 2, ea_); \
        SC_LOAD_EARLY(ea_, 4); SCAN_CONSUME((c0_) + 3, 3, eb_); SC_LOAD_EARLY(eb_, 5); SCAN_CONSUME((c0_) + 4, 4, ea_); SCAN_CONSUME((c0_) + 5, 5, eb_); } while (0)

    if (is_prep) {
        for (int r = 0; r < NROUND; ++r) {
            const int c = NPREP * r + pw;
            int lane_o = F.lane; asm volatile("" : "+v"(lane_o));
            const int lane = lane_o, l16 = lane & 15, gq = lane >> 4;
#pragma unroll
            for (int i = 0; i < 4; ++i) { const int tt = 4 * i + gq;
#pragma unroll
                for (int x = 0; x < 5; ++x) *(LAS v2u*)(priv + x * 2048 + tt * 128 + l16 * 8) = pr[x][i]; }
            if (lane < 16) *(LAS float*)(priv + PV_INVN + 4 * lane) = pinv;
            LDS_WAIT();
            if (r + 1 < NROUND) SCAN_LOAD(c + NPREP);
            float g = 1.f; v4u vpk[2], okt[2], ort[2], obt[2], okd[2]; unsigned bkp[16];
            f32x4 inv4[4];
#pragma unroll
            for (int i = 0; i < 4; ++i) inv4[i] = *(const LAS f32x4*)(priv + PV_INVN + 16 * i);
#pragma unroll
            for (int hf = 0; hf < 2; ++hf) {
                float rr[8], kk[8], vv[8], ic[8], ww[8];
                {
                    const int rawo = (l16 >> 2) * 128 + gq * 32 + (l16 & 3) * 8;
#pragma unroll
                    for (int q4 = 0; q4 < 2; ++q4) { const int R0 = 8 * hf + 4 * q4;
                        const s16x4 r4 = __builtin_amdgcn_ds_read_tr16_b64_v4i16((LAS s16x4*)(priv + R0 * 128 + rawo)), k4 = __builtin_amdgcn_ds_read_tr16_b64_v4i16((LAS s16x4*)(priv + 2048 + R0 * 128 + rawo));
                        const s16x4 v4 = __builtin_amdgcn_ds_read_tr16_b64_v4i16((LAS s16x4*)(priv + 4096 + R0 * 128 + rawo)), i4 = __builtin_amdgcn_ds_read_tr16_b64_v4i16((LAS s16x4*)(priv + 6144 + R0 * 128 + rawo));
                        const s16x4 e4 = __builtin_amdgcn_ds_read_tr16_b64_v4i16((LAS s16x4*)(priv + 8192 + R0 * 128 + rawo));
#pragma unroll
                        for (int e = 0; e < 4; ++e) { rr[4 * q4 + e] = bf2f((bf16)r4[e]); kk[4 * q4 + e] = bf2f((bf16)k4[e]); vv[4 * q4 + e] = bf2f((bf16)v4[e]); ic[4 * q4 + e] = bf2f((bf16)i4[e]); ww[4 * q4 + e] = __expf(-bf2f((bf16)e4[e])); } }
                }
                LDS_WAIT();
                float kt8[8], rt8[8], bt8[8], kd8[8];
#pragma unroll
                for (int u = 0; u < 8; ++u) { const int t = 8 * hf + u;
                    const float kap = kk[u] * kkc * inv4[t >> 2][t & 3], kd = kk[u] * (1.0f + (ic[u] - 1.0f) * kac), bet = kap * ic[u];
                    const float gp = g; g *= ww[u]; const float ig = __builtin_amdgcn_rcpf(g);
                    kt8[u] = kap * gp; rt8[u] = rr[u] * g; bt8[u] = bet * ig; kd8[u] = kd * ig; bkp[t] = pk2(bt8[u], kd8[u]); }
                okt[hf].x = pk2(kt8[0], kt8[1]); okt[hf].y = pk2(kt8[2], kt8[3]); okt[hf].z = pk2(kt8[4], kt8[5]); okt[hf].w = pk2(kt8[6], kt8[7]);
                ort[hf].x = pk2(rt8[0], rt8[1]); ort[hf].y = pk2(rt8[2], rt8[3]); ort[hf].z = pk2(rt8[4], rt8[5]); ort[hf].w = pk2(rt8[6], rt8[7]);
                obt[hf].x = pk2(bt8[0], bt8[1]); obt[hf].y = pk2(bt8[2], bt8[3]); obt[hf].z = pk2(bt8[4], bt8[5]); obt[hf].w = pk2(bt8[6], bt8[7]);
                okd[hf].x = pk2(kd8[0], kd8[1]); okd[hf].y = pk2(kd8[2], kd8[3]); okd[hf].z = pk2(kd8[4], kd8[5]); okd[hf].w = pk2(kd8[6], kd8[7]);
                vpk[hf].x = pk2(vv[0], vv[1]); vpk[hf].y = pk2(vv[2], vv[3]); vpk[hf].z = pk2(vv[4], vv[5]); vpk[hf].w = pk2(vv[6], vv[7]);
            }
            asm volatile("" ::: "memory");
#pragma unroll
            for (int hf = 0; hf < 2; ++hf) { *(LAS v4u*)(priv + lane * 32 + 16 * hf) = okt[hf]; *(LAS v4u*)(priv + 2048 + lane * 32 + 16 * hf) = ort[hf]; *(LAS v4u*)(priv + 4096 + lane * 32 + 16 * hf) = obt[hf]; *(LAS v4u*)(priv + 6144 + lane * 32 + 16 * hf) = okd[hf]; }
            *(LAS v4u*)(priv + 8192 + lane * 32) = vpk[0]; *(LAS v4u*)(priv + 8192 + lane * 32 + 16) = vpk[1]; *(LAS float*)(priv + 10240 + 4 * lane) = g;
            f32x4 gN = {0.f, 0.f, 0.f, 0.f}; gKK = gN; gKR = gN; gBR = gN;
            const int troff = (l16 >> 2) * 32 + (l16 & 3) * 8;
#pragma unroll
            for (int ks = 0; ks < 2; ++ks) { const int off = (32 * ks + 8 * gq) * 32 + troff;
#define SC_TRF(base_) ({ const s16x4 lo_ = __builtin_amdgcn_ds_read_tr16_b64_v4i16((LAS s16x4*)(priv + (base_) + off)), hi_ = __builtin_amdgcn_ds_read_tr16_b64_v4i16((LAS s16x4*)(priv + (base_) + off + 128)); (bf16x8){lo_[0], lo_[1], lo_[2], lo_[3], hi_[0], hi_[1], hi_[2], hi_[3]}; })
                const bf16x8 a1 = SC_TRF(0), a2 = SC_TRF(2048), b1 = SC_TRF(4096), b2 = SC_TRF(6144);
#undef SC_TRF
                gN = __builtin_amdgcn_mfma_f32_16x16x32_bf16(a1, b1, gN, 0, 0, 0); gKK = __builtin_amdgcn_mfma_f32_16x16x32_bf16(a1, b2, gKK, 0, 0, 0);
                gKR = __builtin_amdgcn_mfma_f32_16x16x32_bf16(a2, b2, gKR, 0, 0, 0); gBR = __builtin_amdgcn_mfma_f32_16x16x32_bf16(a2, b1, gBR, 0, 0, 0); }
            LAS float* coef = (LAS float*)(priv + PV_COEF);
#pragma unroll
            for (int e = 0; e < 4; ++e) { const int t = 4 * gq + e; const bool lt = l16 < t, le = l16 <= t;
                coef[t * 16 + l16] = lt ? gN[e] : 0.f; gKK[e] = lt ? gKK[e] : 0.f; gKR[e] = le ? gKR[e] : 0.f; gBR[e] = le ? -gBR[e] : 0.f; }
#pragma unroll
            for (int g4 = 0; g4 < 4; ++g4) { float kd4[4], bt4[4];
#pragma unroll
                for (int j = 0; j < 4; ++j) { const unsigned w = bkp[4 * g4 + j]; bt4[j] = -g * bflo(w); kd4[j] = g * bfhi(w); }
                v4u a2; a2.x = pk2(kd4[0], kd4[1]); a2.y = pk2(kd4[2], kd4[3]); a2.z = pk2(bt4[0], bt4[1]); a2.w = pk2(bt4[2], bt4[3]);
                *(LAS v4u*)(priv + 4096 + lane * 64 + g4 * 16) = a2; }
            LDS_WAIT();
            f32x2 T2[8];
#pragma unroll
            for (int i = 0; i < 8; ++i) T2[i] = (f32x2){0.f, 0.f};
#pragma unroll
            for (int t = 0; t < 16; ++t) {
                f32x2 a2 = {(l16 == t) ? 1.0f : 0.0f, 0.f};
#pragma unroll
                for (int s4 = 0; s4 < (t + 3) / 4; ++s4) { const f32x4 cn = *(const LAS f32x4*)(coef + t * 16 + 4 * s4);
                    a2 -= (f32x2){cn[0], cn[1]} * T2[2 * s4]; if (4 * s4 + 2 < t) a2 -= (f32x2){cn[2], cn[3]} * T2[2 * s4 + 1]; }
                const float tv = a2.x + a2.y; Tcol[t] = tv; if (t & 1) T2[t >> 1].y = tv; else T2[t >> 1].x = tv;
            }
            asm volatile("s_waitcnt lgkmcnt(0)\n\ts_barrier" ::: "memory");
            {
            LAS unsigned char* sl = slots + pw * SLOT_BYTES; int lane_o = F.lane; asm volatile("" : "+v"(lane_o)); const int lane = lane_o, l16 = lane & 15, gq = lane >> 4;
            { const v4u k0 = *(const LAS v4u*)(priv + lane * 32), k1 = *(const LAS v4u*)(priv + lane * 32 + 16), r0 = *(const LAS v4u*)(priv + 2048 + lane * 32), r1 = *(const LAS v4u*)(priv + 2048 + lane * 32 + 16);
              *(LAS v4u*)(sl + SL_KT + lane * 32) = k0; *(LAS v4u*)(sl + SL_KT + lane * 32 + 16) = k1; *(LAS v4u*)(sl + SL_RT + lane * 32) = r0; *(LAS v4u*)(sl + SL_RT + lane * 32 + 16) = r1; }
            if (gq == 0) {
#pragma unroll
                for (int t = 0; t < 16; ++t) *(LAS bf16*)(sl + SL_T + t * 32 + 2 * l16) = (bf16)f2bf(Tcol[t]); }
#pragma unroll
            for (int e = 0; e < 4; ++e) { const int t = 4 * gq + e;
                *(LAS bf16*)(sl + SL_KK + t * 32 + 2 * l16) = (bf16)f2bf(gKK[e]); *(LAS bf16*)(sl + SL_KR + t * 32 + 2 * l16) = (bf16)f2bf(gKR[e]); *(LAS bf16*)(sl + SL_BR + t * 32 + 2 * l16) = (bf16)f2bf(gBR[e]); }
            { const v4u v0 = *(const LAS v4u*)(priv + 8192 + lane * 32), v1 = *(const LAS v4u*)(priv + 8192 + lane * 32 + 16); const float gc = *(const LAS float*)(priv + 10240 + 4 * lane);
              *(LAS v4u*)(sl + SL_V + lane * 32) = v0; *(LAS v4u*)(sl + SL_V + lane * 32 + 16) = v1; *(LAS float*)(sl + SL_GC + 4 * lane) = gc; }
#pragma unroll
            for (int g4 = 0; g4 < 4; ++g4) *(LAS v4u*)(sl + SL_A2 + lane * 64 + g4 * 16) = *(const LAS v4u*)(priv + 4096 + lane * 64 + g4 * 16);
            }
            asm volatile("s_waitcnt lgkmcnt(0)\n\ts_barrier" ::: "memory");
        }
    } else {
        for (int r = 0; r < NROUND; ++r) {
            if (r > 0) SCAN_CONSUME_ROUND(NPREP * (r - 1));
            asm volatile("s_waitcnt lgkmcnt(0)\n\ts_barrier" ::: "memory");
            asm volatile("s_waitcnt lgkmcnt(0)\n\ts_barrier" ::: "memory");
        }
        SCAN_CONSUME_ROUND(NPREP * (NROUND - 1));
    }
#undef SCAN_LOAD
#undef SCAN_CONSUME
#undef SC_TKF
#undef SC_PERM2
#undef SC_PF
#undef SC_LOAD_EARLY
#undef SCAN_CONSUME_ROUND
}

__device__ __forceinline__ unsigned att_off(unsigned row, unsigned ch) { return 256u * row + 16u * (ch ^ (((row & 3u) << 2) | ((row >> 2) & 3u))); }
constexpr int ATT_KV_BYTES = 16384, ATT_BUF_BYTES = 2 * ATT_KV_BYTES;
__device__ __forceinline__ void attn_tile_info(int ti, int n, int b, int& krow0, int& mode) {
    if (ti < 2) { krow0 = b * T + n * 128 + ti * 64; mode = 0; }
    else if (ti < 6) { krow0 = M_LAT + b * LC + (ti - 2) * 64; mode = 0; }
    else if (ti < 8) { krow0 = b * T + (n - 1) * 128 + (ti - 6) * 64; mode = (n == 0) ? -1 : 1; }
    else { krow0 = b * T + (n + 1) * 128 + (ti - 8) * 64; mode = (n == 63) ? -1 : 2; }
}
__device__ __forceinline__ void attn_stage(Frame& F, const bf16* QKV, int krow0, int hk, int buf) {
    const int lane = F.lane, cpos = lane & 15;
#pragma unroll
    for (int i = 0; i < 2; ++i) { const int piece = F.wave * 2 + i, row = piece * 4 + (lane >> 4);
        const int ch = cpos ^ (((row & 3) << 2) | ((row >> 2) & 3));
        const int vkey = 32 * (row >> 5) + 16 * ((row >> 2) & 1) + 4 * ((row >> 3) & 3) + (row & 3);
        LAS unsigned char* kd = F.lds + RING_OFF + buf * ATT_BUF_BYTES + piece * 1024;
        __builtin_amdgcn_global_load_lds((const unsigned*)(QKV + (size_t)(krow0 + row) * NQKV + 2048 + hk * 128 + ch * 8), (LAS unsigned*)kd, 16, 0, 0);
        __builtin_amdgcn_global_load_lds((const unsigned*)(QKV + (size_t)(krow0 + vkey) * NQKV + 2560 + hk * 128 + ch * 8), (LAS unsigned*)(kd + ATT_KV_BYTES), 16, 0, 0); }
}
__device__ __forceinline__ void attn_unit(Frame& F, int unit) {
    const int hh = unit & 1, hk = (unit >> 1) & 3, n = (unit >> 3) & 63, b = unit >> 9;
    const int w = F.wave, lane = F.lane, l16 = lane & 15, gq = lane >> 4;
    const int head = hk * 4 + hh * 2 + (w >> 2), qoff = (w & 3) * 32;
    const bf16* QKV = (const bf16*)(F.ws + WS_IPQKV);
    const float sink = F.in[I_SINK][head];
    const float scale_l2 = 0.08838834764831845f * 1.4426950408889634f;
    __syncthreads();
    attn_stage(F, QKV, b * T + n * 128, hk, 0);
    bf16x8 qf[2][4];
#pragma unroll
    for (int nt = 0; nt < 2; ++nt)
#pragma unroll
        for (int ks = 0; ks < 4; ++ks) qf[nt][ks] = *(const bf16x8*)(QKV + (size_t)(b * T + n * 128 + qoff + nt * 16 + l16) * NQKV + head * 128 + ks * 32 + gq * 8);
    f32x4 oacc[8][2];
#pragma unroll
    for (int dm = 0; dm < 8; ++dm) { oacc[dm][0] = (f32x4){0.f, 0.f, 0.f, 0.f}; oacc[dm][1] = (f32x4){0.f, 0.f, 0.f, 0.f}; }
    float mrun[2] = {-1e30f, -1e30f}, lrun[2] = {0.f, 0.f};
    const int cnt = 10 - (n == 0 ? 2 : 0) - (n == 63 ? 2 : 0);
    { int kr1, md1; attn_tile_info(1, n, b, kr1, md1); attn_stage(F, QKV, kr1, hk, 1); }
    asm volatile("s_waitcnt vmcnt(4)" ::: "memory"); __syncthreads();
    int pb = 0;
    for (int i = 0; i < cnt; ++i) {
        const int ti = (n == 0 && i >= 6) ? i + 2 : i;
        int krow0, mode; attn_tile_info(ti, n, b, krow0, mode);
        const bool more = i + 2 < cnt;
        if (more) { const int tn = (n == 0 && i + 2 >= 6) ? i + 4 : i + 2; int kr2, md2; attn_tile_info(tn, n, b, kr2, md2); attn_stage(F, QKV, kr2, hk, pb >= 1 ? pb - 1 : 2); }
        {
            const LAS unsigned char* Kimg = F.lds + RING_OFF + pb * ATT_BUF_BYTES; const LAS unsigned char* Vimg = Kimg + ATT_KV_BYTES;
            const int joff = (ti & 1) * 64;
            f32x4 sacc[4][2];
#pragma unroll
            for (int mt = 0; mt < 4; ++mt) { sacc[mt][0] = (f32x4){0.f, 0.f, 0.f, 0.f}; sacc[mt][1] = (f32x4){0.f, 0.f, 0.f, 0.f}; }
#pragma unroll
            for (int ks = 0; ks < 4; ++ks)
#pragma unroll
                for (int mt = 0; mt < 4; ++mt) { const bf16x8 kf = *(const LAS bf16x8*)(Kimg + att_off((unsigned)(mt * 16 + l16), (unsigned)(4 * ks + gq)));
                    sacc[mt][0] = __builtin_amdgcn_mfma_f32_16x16x32_bf16(kf, qf[0][ks], sacc[mt][0], 0, 0, 0);
                    sacc[mt][1] = __builtin_amdgcn_mfma_f32_16x16x32_bf16(kf, qf[1][ks], sacc[mt][1], 0, 0, 0); }
            bf16x8 pf[2][2];
#pragma unroll
            for (int nt = 0; nt < 2; ++nt) {
                const int qi = qoff + nt * 16 + l16;
                float mx = -1e30f, sc = scale_l2;
                if (mode == 0) {
#pragma unroll
                    for (int mt = 0; mt < 4; ++mt)
#pragma unroll
                        for (int e = 0; e < 4; ++e) mx = fmaxf(mx, sacc[mt][nt][e]);
                    mx *= scale_l2;
                } else {
#pragma unroll
                    for (int mt = 0; mt < 4; ++mt)
#pragma unroll
                        for (int e = 0; e < 4; ++e) { float s = sacc[mt][nt][e] * scale_l2; const int kj = joff + mt * 16 + 4 * gq + e;
                            if (mode == 1 && kj < qi) s = -1e30f; if (mode == 2 && kj > qi) s = -1e30f; sacc[mt][nt][e] = s; mx = fmaxf(mx, s); }
                    sc = 1.0f;
                }
                mx = rows_max(mx);
                const float mnew = fmaxf(mrun[nt], mx), alpha = __builtin_amdgcn_exp2f(mrun[nt] - mnew);
                float ps = 0.f; float p[4][4];
#pragma unroll
                for (int mt = 0; mt < 4; ++mt)
#pragma unroll
                    for (int e = 0; e < 4; ++e) { p[mt][e] = __builtin_amdgcn_exp2f(fmaf(sacc[mt][nt][e], sc, -mnew)); ps += p[mt][e]; }
                ps = rows_sum(ps);
                lrun[nt] = lrun[nt] * alpha + ps; mrun[nt] = mnew;
#pragma unroll
                for (int dm = 0; dm < 8; ++dm) oacc[dm][nt] = oacc[dm][nt] * alpha;
#pragma unroll
                for (int kp = 0; kp < 2; ++kp) { v4u wv; wv.x = pk2(p[2 * kp][0], p[2 * kp][1]); wv.y = pk2(p[2 * kp][2], p[2 * kp][3]); wv.z = pk2(p[2 * kp + 1][0], p[2 * kp + 1][1]); wv.w = pk2(p[2 * kp + 1][2], p[2 * kp + 1][3]);
                    pf[nt][kp] = __builtin_bit_cast(bf16x8, wv); }
            }
            const unsigned q4 = (unsigned)(l16 >> 2), p4 = (unsigned)(lane & 3);
#pragma unroll
            for (int dm = 0; dm < 8; ++dm)
#pragma unroll
                for (int kp = 0; kp < 2; ++kp) {
                    const s16x4 v0 = __builtin_amdgcn_ds_read_tr16_b64_v4i16((LAS s16x4*)(Vimg + att_off((unsigned)(32 * kp + 8 * gq) + q4, (unsigned)(2 * dm) + (p4 >> 1)) + 8u * (p4 & 1u)));
                    const s16x4 v1 = __builtin_amdgcn_ds_read_tr16_b64_v4i16((LAS s16x4*)(Vimg + att_off((unsigned)(32 * kp + 8 * gq + 4) + q4, (unsigned)(2 * dm) + (p4 >> 1)) + 8u * (p4 & 1u)));
                    const bf16x8 vf = (bf16x8){v0[0], v0[1], v0[2], v0[3], v1[0], v1[1], v1[2], v1[3]};
                    oacc[dm][0] = __builtin_amdgcn_mfma_f32_16x16x32_bf16(vf, pf[0][kp], oacc[dm][0], 0, 0, 0);
                    oacc[dm][1] = __builtin_amdgcn_mfma_f32_16x16x32_bf16(vf, pf[1][kp], oacc[dm][1], 0, 0, 0); }
        }
        if (more) asm volatile("s_waitcnt vmcnt(4)" ::: "memory"); else asm volatile("s_waitcnt vmcnt(0)" ::: "memory");
        __syncthreads();
        pb = pb == 2 ? 0 : pb + 1;
    }
    bf16* MA = (bf16*)(F.ws + WS_MA);
    const float sk2 = sink * 1.4426950408889634f;
#pragma unroll
    for (int nt = 0; nt < 2; ++nt) {
        const float mf = fmaxf(mrun[nt], sk2), a = exp2f(mrun[nt] - mf), l = lrun[nt] * a + exp2f(sk2 - mf), sc = a / l;
        bf16* orow = MA + (size_t)(b * T + n * 128 + qoff + nt * 16 + l16) * D + C + head * 128 + 4 * gq;
#pragma unroll
        for (int dm = 0; dm < 8; ++dm) { const f32x4 o = oacc[dm][nt] * sc; v2u wv; wv.x = pk2(o[0], o[1]); wv.y = pk2(o[2], o[3]); *(v2u*)(orow + dm * 16) = wv; }
    }
}

__device__ __forceinline__ void p7_rwkv_out(Frame& F) {
    const int gw = F.blk * NWAVES + F.wave, NGW = F.G * NWAVES, lane = F.lane;
    const bf16* Y0 = (const bf16*)F.out; const bf16* Y1 = Y0 + (size_t)M_LAT * C;
    const bf16* Vb = (const bf16*)(F.ws + WS_V); const float* BON = (const float*)(F.ws + WS_BONUS);
    const bf16* Gb = (const bf16*)(F.ws + WS_G); bf16* MA = (bf16*)(F.ws + WS_MA);
#pragma unroll 1
    for (int it = gw; it < (M_LAT / 4) * NH; it += NGW) {
        const int m0 = (it >> 5) * 4, h = it & 31, ch = h * HS + lane;
        const v2u ya = *(const v2u*)(Y0 + ((size_t)(m0 >> 2) * C + ch) * 4), yb = *(const v2u*)(Y1 + ((size_t)(m0 >> 2) * C + ch) * 4);
        const float ys[4] = {bflo(ya.x) + bflo(yb.x), bfhi(ya.x) + bfhi(yb.x), bflo(ya.y) + bflo(yb.y), bfhi(ya.y) + bfhi(yb.y)};
        float y[4], v[4], g[4], bonus[4];
#pragma unroll
        for (int u = 0; u < 4; ++u) { const size_t o = (size_t)(m0 + u) * C + ch;
            y[u] = ys[u]; v[u] = bf2f(Vb[o]); g[u] = bf2f(Gb[o]); bonus[u] = BON[(size_t)(m0 + u) * NH + h]; }
        const float gng = F.in[I_GNG][ch], gnb = F.in[I_GNB][ch];
#pragma unroll
        for (int u = 0; u < 4; ++u) {
            const float mu = wave_sum(y[u]) * (1.0f / 64.0f), dy = y[u] - mu, var = wave_sum(dy * dy) * (1.0f / 64.0f);
            const float yn = dy * (1.0f / sqrtf(var + GN_EPS)) * gng + gnb;
            MA[(size_t)(m0 + u) * D + ch] = (bf16)f2bf((yn + bonus[u] * v[u]) * g[u]); }
    }
}

__device__ __forceinline__ void p11_ln1(Frame& F) {
    const int gw = F.blk * NWAVES + F.wave, NGW = F.G * NWAVES, lane = F.lane;
    const float* Z = F.out; float* ST = (float*)(F.ws + WS_X1); bf16* H2 = (bf16*)(F.ws + WS_H2); const float* MOD = (const float*)(F.ws + WS_MOD);
    const float* lg = F.in[I_LN1G]; const float* lb = F.in[I_LN1B];
    for (int m = gw; m < M_LAT; m += NGW) {
        const float* z = Z + (size_t)m * D; f32x4 v[16]; float s = 0.f;
#pragma unroll
        for (int j = 0; j < 16; ++j) { v[j] = *(const f32x4*)(z + 4 * lane + 256 * j); s += (v[j][0] + v[j][1]) + (v[j][2] + v[j][3]); }
        const float mean = wave_sum(s) * (1.0f / D); float q = 0.f;
#pragma unroll
        for (int j = 0; j < 16; ++j) { v[j] = v[j] - mean; q += (v[j][0] * v[j][0] + v[j][1] * v[j][1]) + (v[j][2] * v[j][2] + v[j][3] * v[j][3]); }
        const float rstd = 1.0f / sqrtf(wave_sum(q) * (1.0f / D) + LN_EPS);
        const float* sh2 = MOD + (size_t)(m >> 13) * NMOD + 3 * D; const float* sc2 = sh2 + D;
        if (lane == 0) { ST[2 * m] = mean; ST[2 * m + 1] = rstd; } v2u* ho = (v2u*)(H2 + (size_t)m * D);
#pragma unroll
        for (int j = 0; j < 16; ++j) { const int c = 4 * lane + 256 * j;
            const f32x4 x1 = v[j] * rstd * *(const f32x4*)(lg + c) + *(const f32x4*)(lb + c);
            const f32x4 hv = x1 * (*(const f32x4*)(sc2 + c) + 1.0f) + *(const f32x4*)(sh2 + c);
            v2u w; w.x = pk2(hv[0], hv[1]); w.y = pk2(hv[2], hv[3]); ho[lane + 64 * j] = w; }
    }
}
__device__ __forceinline__ void p14_ln2(Frame& F) {
    const int gw = F.blk * NWAVES + F.wave, NGW = F.G * NWAVES, lane = F.lane;
    float* Z = F.out; const float* lg = F.in[I_LN2G]; const float* lb = F.in[I_LN2B];
    for (int m = gw; m < M_LAT; m += NGW) {
        float* z = Z + (size_t)m * D; f32x4 v[16]; float s = 0.f;
#pragma unroll
        for (int j = 0; j < 16; ++j) { v[j] = *(const f32x4*)(z + 4 * lane + 256 * j); s += (v[j][0] + v[j][1]) + (v[j][2] + v[j][3]); }
        const float mean = wave_sum(s) * (1.0f / D); float q = 0.f;
#pragma unroll
        for (int j = 0; j < 16; ++j) { v[j] = v[j] - mean; q += (v[j][0] * v[j][0] + v[j][1] * v[j][1]) + (v[j][2] * v[j][2] + v[j][3] * v[j][3]); }
        const float rstd = 1.0f / sqrtf(wave_sum(q) * (1.0f / D) + LN_EPS);
#pragma unroll
        for (int j = 0; j < 16; ++j) { const int c = 4 * lane + 256 * j; *(f32x4*)(z + c) = v[j] * rstd * *(const f32x4*)(lg + c) + *(const f32x4*)(lb + c); }
    }
}

struct Args { const float* in[29]; float* out; unsigned char* ws; int ph_lo, ph_hi; };
__global__ void __launch_bounds__(NTHR, 2) mk_fwd(Args args) {
    extern __shared__ __attribute__((aligned(16))) unsigned char lds[];
    Frame F;
    F.lds = (LAS unsigned char*)lds;
    F.tid = threadIdx.x; F.lane = F.tid & 63; F.wave = __builtin_amdgcn_readfirstlane(F.tid >> 6);
    F.G = gridDim.x; F.blk = blockIdx.x;
#pragma unroll
    for (int i = 0; i < 29; ++i) F.in[i] = args.in[i];
    F.out = args.out; F.ws = args.ws;
    volatile LAS unsigned* MISC = (volatile LAS unsigned*)(F.lds + MISC_OFF);
    for (int u = F.tid; u < (LDS_BYTES - LDSCTL_OFF) / 4; u += NTHR) ((LAS unsigned*)(F.lds + LDSCTL_OFF))[u] = 0u;
    __syncthreads();
    unsigned* ctl = (unsigned*)(F.ws + WS_CTL);
    XcdBarrier bar; bar.bar = ctl + CW_BAR; bar.x = 0; bar.st = nullptr;
    if (MK_N_LAUNCHES == 1) bar = xcd_barrier_post(ctl + CW_BAR, MISC + 8);
    const int lo = args.ph_lo, hi = args.ph_hi;
#define IN(k) (lo <= (k) && (k) < hi)
#define SEAM(k) do { if (IN(k) && IN((k) + 1)) xcd_barrier(bar); } while (0)
    LAS unsigned char* ring = F.lds + RING_OFF;
    bf16* W1 = (bf16*)(F.ws + WS_W1); bf16* H = (bf16*)(F.ws + WS_H);
    const float* MOD = (const float*)(F.ws + WS_MOD);

    if (IN(0)) { p0_convert_a(F); } SEAM(0);
    if (IN(1)) { p1_mod(F); } SEAM(1);
    if (IN(2)) { p2_modulate(F); } SEAM(2);
    if (IN(3)) {
        pg8::Gemm g{H, W1, M_ALL, N_INP, D, D, D}; pg8::InprojOrder S; S.init(F.G, F.blk);
        pg8::EpiInproj E{(bf16*)(F.ws + WS_IPRW), (bf16*)(F.ws + WS_IPQKV), (bf16*)(F.ws + WS_IPGATE), (const float*)(F.ws + WS_ROPE)};
        pg8::gemm_phase<pg8::EpiInproj, pg8::InprojOrder, true, true>(ring, g, S, E);
    } SEAM(3);
    if (IN(4)) { p4_features_mfma<0>(F, 0, F.G); }
    SEAM(5);
    if (IN(6)) {
        if (F.blk < 128) p5_scan(F);
        else { for (int u = F.blk - 128; u < 1024; u += F.G - 128) attn_unit(F, u); __syncthreads(); p4_features_mfma<1>(F, 128, F.G - 128); __syncthreads(); p_convert_ffn(F, 128, F.G - 128, 0); }
    } SEAM(6);
    if (IN(7)) { p7_rwkv_out(F); } SEAM(7);
    if (IN(8)) {
        pg8::Gemm g{(const bf16*)(F.ws + WS_MA), (const bf16*)(F.ws + WS_WOCAT), M_LAT, D, D, D, D}; pg8::StaticOrder S; S.init(M_LAT, D, F.G, F.blk);
        pg8::EpiGateMerged E{(const bf16*)(F.ws + WS_IPGATE), NGATE, (bf16*)(F.ws + WS_MERGED)};
        pg8::gemm_phase<pg8::EpiGateMerged, pg8::StaticOrder, true, true>(ring, g, S, E);
    } SEAM(8);
    if (IN(10)) {
        pg8::Gemm g{(const bf16*)(F.ws + WS_MERGED), (const bf16*)(F.ws + WS_WOUT), M_LAT, D, D, D, D}; pg8::StaticOrder S; S.init(M_LAT, D, F.G, F.blk);
        pg8::EpiResid E{F.in[I_X], F.out, MOD + 2 * D, NMOD, ALPHA};
        pg8::gemm_phase<pg8::EpiResid, pg8::StaticOrder, true, true>(ring, g, S, E);
    } SEAM(10);
    if (IN(11)) { p11_ln1(F); } SEAM(11);
    if (IN(12)) {
        pg8::Gemm g{(const bf16*)(F.ws + WS_H2), (const bf16*)(F.ws + WS_WGU), M_LAT, 2 * DFF, D, D, D}; pg8::StaticOrder S; S.init(M_LAT, 2 * DFF, F.G, F.blk);
        pg8::EpiSwiglu E{(bf16*)(F.ws + WS_ACT), DFF};
        pg8::gemm_phase<pg8::EpiSwiglu, pg8::StaticOrder, true, true>(ring, g, S, E);
        { const int tail = S.nwg % F.G;
          if (tail > 0 && F.blk >= tail) p_convert_ffn(F, tail, F.G - tail, 1); else if (tail == 0) p_convert_ffn(F, 0, F.G, 1); }
    } SEAM(12);
    if (IN(13)) {
        pg8::Gemm g{(const bf16*)(F.ws + WS_ACT), (const bf16*)(F.ws + WS_WDN), M_LAT, D, DFF, DFF, DFF}; pg8::StaticOrder S; S.init(M_LAT, D, F.G, F.blk);
        pg8::EpiResidLn E{F.out, (const float*)(F.ws + WS_X1), F.in[I_LN1G], F.in[I_LN1B], MOD + 5 * D, NMOD, ALPHA};
        pg8::gemm_phase<pg8::EpiResidLn, pg8::StaticOrder, true, true>(ring, g, S, E);
    } SEAM(13);
    if (IN(14)) { p14_ln2(F); }
#undef IN
#undef SEAM
}

extern "C" void kernel_launch(void* const* d_in, const int* in_sizes, int n_in, void* d_out, int out_size, void* d_ws, size_t ws_size, hipStream_t stream) {
    static int grid = 0;
    if (grid == 0) {
        if (n_in != 29 || in_sizes[0] != M_LAT * D || out_size != M_LAT * D || ws_size < WS_END) { fprintf(stderr, "kernel_launch: unexpected shapes (n_in %d, in0 %d, out %d, ws %zu < %zu)\n", n_in, n_in > 0 ? in_sizes[0] : -1, out_size, ws_size, (size_t)WS_END); grid = -1; return; }
        int dev = 0, cus = 0, per_cu = 0;
        if (hipGetDevice(&dev) != hipSuccess || hipDeviceGetAttribute(&cus, hipDeviceAttributeMultiprocessorCount, dev) != hipSuccess) { grid = -1; return; }
        if (hipFuncSetAttribute((const void*)mk_fwd, hipFuncAttributeMaxDynamicSharedMemorySize, LDS_BYTES) != hipSuccess) { fprintf(stderr, "kernel_launch: hipFuncSetAttribute failed\n"); grid = -1; return; }
        if (hipOccupancyMaxActiveBlocksPerMultiprocessor(&per_cu, (const void*)mk_fwd, NTHR, LDS_BYTES) != hipSuccess || per_cu < 1) fprintf(stderr, "kernel_launch: occupancy query reports %d\n", per_cu);
        (void)hipGetLastError();
        grid = cus;
        if (grid < 256) { fprintf(stderr, "kernel_launch: %d CUs < 256\n", grid); }
    }
    if (grid < 0) return;
    if (hipMemsetAsync((char*)d_ws + WS_CTL, 0, CTL_ZERO_BYTES, stream) != hipSuccess) return;
    Args a{};
    for (int i = 0; i < 29; ++i) a.in[i] = (const float*)d_in[i];
    a.out = (float*)d_out; a.ws = (unsigned char*)d_ws;
#if MK_N_LAUNCHES == 1
    a.ph_lo = 0; a.ph_hi = NPHASE;
    hipLaunchKernelGGL(mk_fwd, dim3(grid), dim3(NTHR), LDS_BYTES, stream, a);
#else
    for (int p = 0; p < NPHASE; ++p) for (int rep = 0; rep < 1 + ((REPMASK >> p) & 1); ++rep) { a.ph_lo = p; a.ph_hi = p + 1; hipLaunchKernelGGL(mk_fwd, dim3(grid), dim3(NTHR), LDS_BYTES, stream, a); }
#endif
}
```

```cpp
#include <hip/hip_runtime.h>
#include <cstdio>
#include <cstdint>
#define LAS __attribute__((address_space(3)))
namespace pg8 {
#define PG8_LAS __attribute__((address_space(3)))
typedef unsigned short bf16_t;
typedef short bf16x8 __attribute__((ext_vector_type(8)));
typedef float f32x4 __attribute__((ext_vector_type(4)));
typedef unsigned u32x4 __attribute__((ext_vector_type(4)));
constexpr int BM = 256, BK = 64, HALF = 128, HTB = HALF * BK * 2  , STAGE_BYTES = 8 * HTB, NXCD = 8, WGM = 8;

__host__ __device__ __forceinline__ int lds_byte(int r, int c) { const int st = (r >> 4) * 2 + (c >> 5), rr = r & 15, cc = c & 31, ob = rr * 64 + cc * 2; return st * 1024 + (ob ^ (((ob >> 9) & 1) << 5)); }
__host__ __device__ __forceinline__ void stage_rc(int b, int& R, int& C) { const int st = b / 1024, sb = b % 1024, swz = sb ^ (((sb >> 9) & 1) << 5); R = (st >> 1) * 16 + swz / 64; C = (st & 1) * 32 + (swz % 64) / 2; }
__host__ __device__ __forceinline__ int perm32(int rho) { const int n = rho >> 4, i = rho & 15; return 8 * (i >> 2) + 4 * n + (i & 3); }

struct Unit { int pm, pn; };
struct Gemm { const bf16_t* A; const bf16_t* Bt; int M, N, K, lda, ldb; };

struct StaticOrder {
    int nM, nN, nwg, G, c;
    __host__ __device__ void init(int M, int N, int G_, int c_) { nM = M / BM; nN = N / BM; nwg = nM * nN; G = G_; c = c_; }
    __host__ __device__ bool next(int i, Unit& u) const {
        const long L = (long)i * G + c; if (L >= nwg) return false;
        int wgid = (int)L; { const int q = nwg / NXCD, r = nwg % NXCD, xcd = wgid % NXCD, off = wgid / NXCD; wgid = (xcd < r ? xcd * (q + 1) : r * (q + 1) + (xcd - r) * q) + off; }
        const int nig = WGM * nN, gid = wgid / nig, fm = gid * WGM, gsz = (nM - fm) < WGM ? (nM - fm) : WGM;
        u.pm = fm + ((wgid % nig) % gsz); u.pn = (wgid % nig) / gsz; return true;
    }
    __device__ __forceinline__ void a_ready(const Unit&) const {}
    __device__ __forceinline__ void done(const Unit&) const {}
};

struct InprojOrder {
    StaticOrder lat; int G, c;
    __host__ __device__ void init(int G_, int c_) { lat.init(64 * BM, 71 * BM, G_, c_); G = G_; c = c_; }
    __host__ __device__ bool next(int i, Unit& u) const {
        const long L = (long)i * G + c; if (L < lat.nwg) return lat.next(i, u);
        const int j = (int)(L - lat.nwg); if (j >= 62) return false;
        const int jj = j % 31; u.pm = 64 + j / 31; u.pn = jj < 27 ? jj : jj + 8; return true;
    }
    __device__ __forceinline__ void a_ready(const Unit&) const {}
    __device__ __forceinline__ void done(const Unit&) const {}
};

typedef float f32x2c __attribute__((ext_vector_type(2)));
typedef __bf16 bf16x2c __attribute__((ext_vector_type(2)));
__device__ __forceinline__ unsigned cvt_pk_bf16(float lo, float hi) { const f32x2c v = {lo, hi}; return __builtin_bit_cast(unsigned, __builtin_convertvector(v, bf16x2c)); }
__device__ __forceinline__ float bflo(unsigned w) { return __uint_as_float(w << 16); }
__device__ __forceinline__ float bfhi(unsigned w) { return __uint_as_float(w & 0xffff0000u); }
__device__ __forceinline__ float sigm(float x) { return __builtin_amdgcn_rcpf(1.0f + __expf(-x)); }

struct EpiInproj {
    static constexpr bool PERM = true, AFTER_DRAIN = false, HAS_MID = false;
    bf16_t *rw, *qkv, *gate; const float* rope;
    __device__ __forceinline__ void operator()(const f32x4 (&acc)[2][2][4][2], const Unit& u, int wr, int wc, int fr, int fq) const {
        bf16_t* base; int ldc, colt;
        if (u.pn < 27) { base = rw; ldc = 6912; colt = u.pn * BM; }
        else if (u.pn < 39) { base = qkv; ldc = 3072; colt = (u.pn - 27) * BM; }
        else { if (u.pm >= 64) return; base = gate; ldc = 8192; colt = (u.pn - 39) * BM; }
        const int row0 = u.pm * BM + wr * 64 + fr, col0 = colt + wc * 32 + 8 * fq;
        const bool rot = u.pm < 64 && u.pn >= 27 && u.pn < 37;
        if (rot) {
            f32x4 cs[4], sn[4];
#define EI_LOAD(g) do { const int t = (row0 + ((g) >> 2) * HALF + ((g) & 3) * 16) & 8191; cs[(g) & 3] = *(const f32x4*)(rope + (size_t)t * 64 + 4 * (4 * wc + fq)); sn[(g) & 3] = *(const f32x4*)(rope + (size_t)(8192 + t) * 64 + 4 * (4 * wc + fq)); } while (0)
            EI_LOAD(0); EI_LOAD(1); EI_LOAD(2); EI_LOAD(3);
#pragma unroll
            for (int g = 0; g < 8; ++g) { const int ai = g >> 2, m = g & 3;
                asm volatile("" : "+v"(cs[g & 3]), "+v"(sn[g & 3]) :: "memory");
                bf16_t* rowp = base + (size_t)(row0 + ai * HALF + m * 16) * ldc + col0; u32x4 w[2];
#pragma unroll
                for (int bj = 0; bj < 2; ++bj) { const f32x4 v0 = acc[ai][bj][m][0], v1 = acc[ai][bj][m][1]; const f32x4 a = v0 * cs[g & 3] - v1 * sn[g & 3], b = v1 * cs[g & 3] + v0 * sn[g & 3];
                    w[bj].x = cvt_pk_bf16(a[0], a[1]); w[bj].y = cvt_pk_bf16(a[2], a[3]); w[bj].z = cvt_pk_bf16(b[0], b[1]); w[bj].w = cvt_pk_bf16(b[2], b[3]); }
                if (g + 4 < 8) EI_LOAD(g + 4);
                *(u32x4*)rowp = w[0]; *(u32x4*)(rowp + HALF) = w[1]; }
#undef EI_LOAD
            return;
        }
#pragma unroll
        for (int ai = 0; ai < 2; ++ai)
#pragma unroll
            for (int m = 0; m < 4; ++m) { bf16_t* rowp = base + (size_t)(row0 + ai * HALF + m * 16) * ldc + col0;
#pragma unroll
                for (int bj = 0; bj < 2; ++bj) { const f32x4 v0 = acc[ai][bj][m][0], v1 = acc[ai][bj][m][1];
                    u32x4 w; w.x = cvt_pk_bf16(v0[0], v0[1]); w.y = cvt_pk_bf16(v0[2], v0[3]); w.z = cvt_pk_bf16(v1[0], v1[1]); w.w = cvt_pk_bf16(v1[2], v1[3]);
                    *(u32x4*)(rowp + bj * HALF) = w; } }
    }
};
struct EpiGate1 {
    static constexpr bool PERM = true, AFTER_DRAIN = false, HAS_MID = false;
    float* T; const bf16_t* gate; int ldg;
    __device__ __forceinline__ void operator()(const f32x4 (&acc)[2][2][4][2], const Unit& u, int wr, int wc, int fr, int fq) const {
        const int row0 = u.pm * BM + wr * 64 + fr, col0 = u.pn * BM + wc * 32 + 8 * fq;
#pragma unroll
        for (int ai = 0; ai < 2; ++ai)
#pragma unroll
            for (int m = 0; m < 4; ++m) { const size_t row = (size_t)(row0 + ai * HALF + m * 16);
#pragma unroll
                for (int bj = 0; bj < 2; ++bj) { const int c = col0 + bj * HALF; const u32x4 gw = *(const u32x4*)(gate + row * ldg + c);
                    const f32x4 v0 = acc[ai][bj][m][0], v1 = acc[ai][bj][m][1];
                    f32x4 o0, o1;
                    o0[0] = sigm(bflo(gw.x)) * v0[0]; o0[1] = sigm(bfhi(gw.x)) * v0[1]; o0[2] = sigm(bflo(gw.y)) * v0[2]; o0[3] = sigm(bfhi(gw.y)) * v0[3];
                    o1[0] = sigm(bflo(gw.z)) * v1[0]; o1[1] = sigm(bfhi(gw.z)) * v1[1]; o1[2] = sigm(bflo(gw.w)) * v1[2]; o1[3] = sigm(bfhi(gw.w)) * v1[3];
                    float* tp = T + row * 4096 + c; *(f32x4*)tp = o0; *(f32x4*)(tp + 4) = o1; } }
    }
};
struct EpiGate2 {
    static constexpr bool PERM = true, AFTER_DRAIN = false, HAS_MID = false;
    const float* T; const bf16_t* gate; int ldg; bf16_t* O;
    __device__ __forceinline__ void operator()(const f32x4 (&acc)[2][2][4][2], const Unit& u, int wr, int wc, int fr, int fq) const {
        const int row0 = u.pm * BM + wr * 64 + fr, col0 = u.pn * BM + wc * 32 + 8 * fq;
#pragma unroll
        for (int ai = 0; ai < 2; ++ai)
#pragma unroll
            for (int m = 0; m < 4; ++m) { const size_t row = (size_t)(row0 + ai * HALF + m * 16);
#pragma unroll
                for (int bj = 0; bj < 2; ++bj) { const int c = col0 + bj * HALF; const u32x4 gw = *(const u32x4*)(gate + row * ldg + c);
                    const float* tp = T + row * 4096 + c; const f32x4 t0 = *(const f32x4*)tp, t1 = *(const f32x4*)(tp + 4);
                    const f32x4 v0 = acc[ai][bj][m][0], v1 = acc[ai][bj][m][1];
                    f32x4 o0, o1;
                    o0[0] = t0[0] + sigm(bflo(gw.x)) * v0[0]; o0[1] = t0[1] + sigm(bfhi(gw.x)) * v0[1]; o0[2] = t0[2] + sigm(bflo(gw.y)) * v0[2]; o0[3] = t0[3] + sigm(bfhi(gw.y)) * v0[3];
                    o1[0] = t1[0] + sigm(bflo(gw.z)) * v1[0]; o1[1] = t1[1] + sigm(bfhi(gw.z)) * v1[1]; o1[2] = t1[2] + sigm(bflo(gw.w)) * v1[2]; o1[3] = t1[3] + sigm(bfhi(gw.w)) * v1[3];
                    u32x4 w; w.x = cvt_pk_bf16(o0[0], o0[1]); w.y = cvt_pk_bf16(o0[2], o0[3]); w.z = cvt_pk_bf16(o1[0], o1[1]); w.w = cvt_pk_bf16(o1[2], o1[3]);
                    *(u32x4*)(O + row * 4096 + c) = w; } }
    }
};
struct EpiResid {
    static constexpr bool PERM = false, AFTER_DRAIN = false, HAS_MID = false;
    const float* X; float* Z; const float* gt; int modstride; float alpha;
    __device__ __forceinline__ void operator()(const f32x4 (&acc)[2][2][4][2], const Unit& u, int wr, int wc, int fr, int fq) const {
        const int row0 = u.pm * BM + wr * 64 + fr, col0 = u.pn * BM + wc * 32 + 4 * fq;
        const float* g = gt + (size_t)((u.pm * BM) >> 13) * modstride;
        f32x4 gv[2][2];
#pragma unroll
        for (int bj = 0; bj < 2; ++bj)
#pragma unroll
            for (int n = 0; n < 2; ++n) gv[bj][n] = *(const f32x4*)(g + col0 + bj * HALF + n * 16);
        f32x4 xb[4][4];
#define ER_LOAD(g_) do { const size_t off_ = (size_t)(row0 + ((g_) >> 2) * HALF + ((g_) & 3) * 16) * 4096 + col0; _Pragma("unroll") for (int bj = 0; bj < 2; ++bj) _Pragma("unroll") for (int n = 0; n < 2; ++n) xb[(g_) & 3][bj * 2 + n] = *(const f32x4*)(X + off_ + bj * HALF + n * 16); } while (0)
        ER_LOAD(0); ER_LOAD(1); ER_LOAD(2); ER_LOAD(3);
#pragma unroll
        for (int gi = 0; gi < 8; ++gi) { const int ai = gi >> 2, m = gi & 3; const size_t off = (size_t)(row0 + ai * HALF + m * 16) * 4096 + col0;
            asm volatile("" : "+v"(xb[gi & 3][0]), "+v"(xb[gi & 3][1]), "+v"(xb[gi & 3][2]), "+v"(xb[gi & 3][3]) :: "memory");
            f32x4 o[4];
#pragma unroll
            for (int bj = 0; bj < 2; ++bj)
#pragma unroll
                for (int n = 0; n < 2; ++n) o[bj * 2 + n] = xb[gi & 3][bj * 2 + n] * alpha + gv[bj][n] * acc[ai][bj][m][n];
            if (gi + 4 < 8) ER_LOAD(gi + 4);
#pragma unroll
            for (int bj = 0; bj < 2; ++bj)
#pragma unroll
                for (int n = 0; n < 2; ++n) *(f32x4*)(Z + off + bj * HALF + n * 16) = o[bj * 2 + n]; }
#undef ER_LOAD
    }
};
struct EpiSwiglu {
    static constexpr bool PERM = true, AFTER_DRAIN = false, HAS_MID = false;
    bf16_t* O; int ldc;
    __device__ __forceinline__ void operator()(const f32x4 (&acc)[2][2][4][2], const Unit& u, int wr, int wc, int fr, int fq) const {
        const int row0 = u.pm * BM + wr * 64 + fr, col0 = u.pn * HALF + wc * 32 + 8 * fq;
#pragma unroll
        for (int ai = 0; ai < 2; ++ai)
#pragma unroll
            for (int m = 0; m < 4; ++m) { bf16_t* rowp = O + (size_t)(row0 + ai * HALF + m * 16) * ldc + col0;
                float o[8];
#pragma unroll
                for (int n = 0; n < 2; ++n)
#pragma unroll
                    for (int e = 0; e < 4; ++e) { const float gg = acc[ai][0][m][n][e], uu = acc[ai][1][m][n][e]; o[n * 4 + e] = gg * sigm(gg) * uu; }
                u32x4 w; w.x = cvt_pk_bf16(o[0], o[1]); w.y = cvt_pk_bf16(o[2], o[3]); w.z = cvt_pk_bf16(o[4], o[5]); w.w = cvt_pk_bf16(o[6], o[7]);
                *(u32x4*)rowp = w; }
    }
};


struct EpiGateMerged {
    static constexpr bool PERM = true, AFTER_DRAIN = false, HAS_MID = true;
    const bf16_t* gate; int ldg; bf16_t* O;
    __device__ __forceinline__ void mid(f32x4 (&acc)[2][2][4][2], const Unit& u, int wr, int wc, int fr, int fq) const {
        int row0 = u.pm * BM + wr * 64 + fr, col0 = u.pn * BM + wc * 32 + 8 * fq; asm volatile("" : "+v"(row0), "+v"(col0));
        u32x4 gr[3][2], ga[3][2];
#define GM_LOAD(i) do { _Pragma("unroll") for (int bj = 0; bj < 2; ++bj) { const bf16_t* p = gate + (size_t)(row0 + ((i) >> 2) * HALF + ((i) & 3) * 16) * ldg + col0 + bj * HALF; gr[(i) % 3][bj] = *(const u32x4*)p; ga[(i) % 3][bj] = *(const u32x4*)(p + 4096); } } while (0)
        GM_LOAD(0); GM_LOAD(1);
#pragma unroll
        for (int i = 0; i < 8; ++i) {
            if (i + 2 < 8) GM_LOAD(i + 2);
            asm volatile("" : "+v"(gr[i % 3][0]), "+v"(gr[i % 3][1]), "+v"(ga[i % 3][0]), "+v"(ga[i % 3][1]) :: "memory");
            const int ai = i >> 2, m = i & 3;
#pragma unroll
            for (int bj = 0; bj < 2; ++bj) { const u32x4 r = gr[i % 3][bj], a = ga[i % 3][bj];
                acc[ai][bj][m][0][0] *= (1.0f + __expf(-bflo(a.x))) * __builtin_amdgcn_rcpf(1.0f + __expf(-bflo(r.x))); acc[ai][bj][m][0][1] *= (1.0f + __expf(-bfhi(a.x))) * __builtin_amdgcn_rcpf(1.0f + __expf(-bfhi(r.x)));
                acc[ai][bj][m][0][2] *= (1.0f + __expf(-bflo(a.y))) * __builtin_amdgcn_rcpf(1.0f + __expf(-bflo(r.y))); acc[ai][bj][m][0][3] *= (1.0f + __expf(-bfhi(a.y))) * __builtin_amdgcn_rcpf(1.0f + __expf(-bfhi(r.y)));
                acc[ai][bj][m][1][0] *= (1.0f + __expf(-bflo(a.z))) * __builtin_amdgcn_rcpf(1.0f + __expf(-bflo(r.z))); acc[ai][bj][m][1][1] *= (1.0f + __expf(-bfhi(a.z))) * __builtin_amdgcn_rcpf(1.0f + __expf(-bfhi(r.z)));
                acc[ai][bj][m][1][2] *= (1.0f + __expf(-bflo(a.w))) * __builtin_amdgcn_rcpf(1.0f + __expf(-bflo(r.w))); acc[ai][bj][m][1][3] *= (1.0f + __expf(-bfhi(a.w))) * __builtin_amdgcn_rcpf(1.0f + __expf(-bfhi(r.w))); }
        }
#undef GM_LOAD
    }
    __device__ __forceinline__ void operator()(const f32x4 (&acc)[2][2][4][2], const Unit& u, int wr, int wc, int fr, int fq) const {
        int row0 = u.pm * BM + wr * 64 + fr, col0 = u.pn * BM + wc * 32 + 8 * fq; asm volatile("" : "+v"(row0), "+v"(col0));
        u32x4 gb[4][2];
#define EG_LOAD(g_) do { const bf16_t* p_ = gate + (size_t)(row0 + ((g_) >> 2) * HALF + ((g_) & 3) * 16) * ldg + 4096 + col0; gb[(g_) & 3][0] = *(const u32x4*)p_; gb[(g_) & 3][1] = *(const u32x4*)(p_ + HALF); } while (0)
        EG_LOAD(0); EG_LOAD(1); EG_LOAD(2); EG_LOAD(3);
#pragma unroll
        for (int gi = 0; gi < 8; ++gi) { const int ai = gi >> 2, m = gi & 3; const size_t row = (size_t)(row0 + ai * HALF + m * 16);
            asm volatile("" : "+v"(gb[gi & 3][0]), "+v"(gb[gi & 3][1]) :: "memory");
            u32x4 w[2];
#pragma unroll
            for (int bj = 0; bj < 2; ++bj) { const u32x4 gw = gb[gi & 3][bj]; const f32x4 v0 = acc[ai][bj][m][0], v1 = acc[ai][bj][m][1];
                w[bj].x = cvt_pk_bf16(sigm(bflo(gw.x)) * v0[0], sigm(bfhi(gw.x)) * v0[1]); w[bj].y = cvt_pk_bf16(sigm(bflo(gw.y)) * v0[2], sigm(bfhi(gw.y)) * v0[3]);
                w[bj].z = cvt_pk_bf16(sigm(bflo(gw.z)) * v1[0], sigm(bfhi(gw.z)) * v1[1]); w[bj].w = cvt_pk_bf16(sigm(bflo(gw.w)) * v1[2], sigm(bfhi(gw.w)) * v1[3]); }
            if (gi + 4 < 8) EG_LOAD(gi + 4);
            *(u32x4*)(O + row * 4096 + col0) = w[0]; *(u32x4*)(O + row * 4096 + col0 + HALF) = w[1]; }
#undef EG_LOAD
    }
};

struct EpiResidLn {
    static constexpr bool PERM = false, AFTER_DRAIN = false, HAS_MID = false;
    float* Zio; const float* stats; const float* g1; const float* b1; const float* gt; int modstride; float alpha;
    __device__ __forceinline__ void operator()(const f32x4 (&acc)[2][2][4][2], const Unit& u, int wr, int wc, int fr, int fq) const {
        const int row0 = u.pm * BM + wr * 64 + fr, col0 = u.pn * BM + wc * 32 + 4 * fq;
        const float* g = gt + (size_t)((u.pm * BM) >> 13) * modstride;
#pragma unroll
        for (int bj = 0; bj < 2; ++bj) {
            f32x4 gv[2], lg[2], lb[2];
#pragma unroll
            for (int n = 0; n < 2; ++n) { const int c = col0 + bj * HALF + n * 16; gv[n] = *(const f32x4*)(g + c); lg[n] = *(const f32x4*)(g1 + c) * alpha; lb[n] = *(const f32x4*)(b1 + c) * alpha; }
            f32x4 zb[4][2]; f32x2c st[4];
#define EL_LOAD(g_) do { const int row_ = row0 + ((g_) >> 2) * HALF + ((g_) & 3) * 16; const float* zp_ = Zio + (size_t)row_ * 4096 + col0 + bj * HALF; zb[(g_) & 3][0] = *(const f32x4*)zp_; zb[(g_) & 3][1] = *(const f32x4*)(zp_ + 16); st[(g_) & 3] = *(const f32x2c*)(stats + 2 * row_); } while (0)
            EL_LOAD(0); EL_LOAD(1); EL_LOAD(2); EL_LOAD(3);
#pragma unroll
            for (int gi = 0; gi < 8; ++gi) { const int ai = gi >> 2, m = gi & 3; float* zp = Zio + (size_t)(row0 + ai * HALF + m * 16) * 4096 + col0 + bj * HALF;
                asm volatile("" : "+v"(zb[gi & 3][0]), "+v"(zb[gi & 3][1]), "+v"(st[gi & 3]) :: "memory");
                const float mean = st[gi & 3][0], rstd = st[gi & 3][1];
                f32x4 o[2];
#pragma unroll
                for (int n = 0; n < 2; ++n) o[n] = (zb[gi & 3][n] - mean) * rstd * lg[n] + lb[n] + gv[n] * acc[ai][bj][m][n];
                if (gi + 4 < 8) EL_LOAD(gi + 4);
                *(f32x4*)zp = o[0]; *(f32x4*)(zp + 16) = o[1]; }
#undef EL_LOAD
        }
    }
};
template <class Epi, class Sched, bool ALIGN_EPI = false, bool SP2 = false>
__device__ __forceinline__ void gemm_phase(PG8_LAS unsigned char* lds, const Gemm g, const Sched& S, const Epi& E) {
    const int tid = threadIdx.x, wid = __builtin_amdgcn_readfirstlane(tid >> 6), lane = tid & 63, wr = wid >> 2, wc = wid & 3, fr = lane & 15, fq = lane >> 4;
    const int K = g.K, nt = K / BK;
    unsigned voffA[2], voffB[2];
#pragma unroll
    for (int i = 0; i < 2; ++i) { int R, C; stage_rc(tid * 16 + i * 8192, R, C); const int Rb = Epi::PERM ? ((R & ~31) + perm32(R & 31)) : R;
        voffA[i] = (unsigned)(R * g.lda + C) * 2u; voffB[i] = (unsigned)(Rb * g.ldb + C) * 2u; }
    const size_t kstep = (size_t)(BK * 2);
    const size_t hstepA = (size_t)HALF * g.lda * 2, hstepB = (size_t)HALF * g.ldb * 2;
    const size_t tstepA = 2 * hstepA, tstepB = 2 * hstepB;
    const unsigned ldsw = (unsigned)wid * 1024u;
    const int aoff = lds_byte(wr * 64 + fr, fq * 8), boff = lds_byte(wc * 32 + fr, fq * 8);
#define PG8_SA(b, h) (((b) * 2 + (h)) * HTB)
#define PG8_SB(b, h) ((4 + (b) * 2 + (h)) * HTB)
#define PG8_STAGE(bufoff, gbase, voff) do { _Pragma("unroll") for (int _i = 0; _i < 2; ++_i) \
        __builtin_amdgcn_global_load_lds((const unsigned*)((const char*)(gbase) + (voff)[_i]), (PG8_LAS unsigned*)(lds + (bufoff) + ldsw + _i * 8192), 16, 0, 0); } while (0)
#define PG8_LDA(dst, b, h) do { _Pragma("unroll") for (int m = 0; m < 4; ++m) _Pragma("unroll") for (int k = 0; k < 2; ++k) dst[m][k] = *(const PG8_LAS bf16x8*)(lds + PG8_SA(b, h) + aoff + m * 2048 + k * 1024); } while (0)
#define PG8_LDB(dst, b, h) do { _Pragma("unroll") for (int n = 0; n < 2; ++n) _Pragma("unroll") for (int k = 0; k < 2; ++k) dst[n][k] = *(const PG8_LAS bf16x8*)(lds + PG8_SB(b, h) + boff + n * 2048 + k * 1024); } while (0)
#define PG8_MMA(ai, bj, At, Bt) do { __builtin_amdgcn_s_setprio(1); _Pragma("unroll") for (int m = 0; m < 4; ++m) _Pragma("unroll") for (int n = 0; n < 2; ++n) _Pragma("unroll") for (int k = 0; k < 2; ++k) \
        acc[ai][bj][m][n] = __builtin_amdgcn_mfma_f32_16x16x32_bf16(Bt[n][k], At[m][k], acc[ai][bj][m][n], 0, 0, 0); __builtin_amdgcn_s_setprio(0); } while (0)
#define PG8_WAIT_V(n) asm volatile("s_waitcnt vmcnt(" #n ")" ::: "memory")
#define PG8_WAIT_L(n) asm volatile("s_waitcnt lgkmcnt(" #n ")" ::: "memory")
#define PG8_BAR __builtin_amdgcn_s_barrier()
#define PG8_SCHED __builtin_amdgcn_sched_barrier(0)
    Unit cur, nxt; int ui = 0;
    if (!S.next(0, cur)) return;
    f32x4 acc[2][2][4][2];
#pragma unroll
    for (int a = 0; a < 2; ++a)
#pragma unroll
        for (int b = 0; b < 2; ++b)
#pragma unroll
            for (int m = 0; m < 4; ++m)
#pragma unroll
                for (int n = 0; n < 2; ++n) acc[a][b][m][n] = (f32x4){0.f, 0.f, 0.f, 0.f};
    bf16x8 At[4][2], B0[2][2], B1[2][2];
    const char* cA = (const char*)g.A + (size_t)cur.pm * tstepA; const char* cB = (const char*)g.Bt + (size_t)cur.pn * tstepB;
    S.a_ready(cur);
    if constexpr (SP2) {
        PG8_STAGE(PG8_SB(0, 0), cB, voffB); PG8_STAGE(PG8_SB(0, 1), cB + hstepB, voffB); PG8_STAGE(PG8_SA(0, 0), cA, voffA); PG8_STAGE(PG8_SA(0, 1), cA + hstepA, voffA);
        if (wr == 1) PG8_BAR;
        PG8_WAIT_V(2); PG8_BAR;
        PG8_STAGE(PG8_SB(1, 0), cB + kstep, voffB); PG8_STAGE(PG8_SA(1, 0), cA + kstep, voffA); PG8_STAGE(PG8_SB(1, 1), cB + hstepB + kstep, voffB);
        PG8_WAIT_V(6); PG8_BAR;
    } else {
        PG8_STAGE(PG8_SB(0, 0), cB, voffB); PG8_STAGE(PG8_SA(0, 0), cA, voffA); PG8_STAGE(PG8_SB(0, 1), cB + hstepB, voffB); PG8_STAGE(PG8_SA(0, 1), cA + hstepA, voffA);
        if (wr == 1) PG8_BAR;
        PG8_WAIT_V(4); PG8_BAR;
        PG8_STAGE(PG8_SB(1, 0), cB + kstep, voffB); PG8_STAGE(PG8_SA(1, 0), cA + kstep, voffA); PG8_STAGE(PG8_SB(1, 1), cB + hstepB + kstep, voffB);
        PG8_WAIT_V(6); PG8_BAR;
    }
    for (;;) {
        const bool has_next = S.next(ui + 1, nxt);
        const char* nA = has_next ? (const char*)g.A + (size_t)nxt.pm * tstepA : cA; const char* nB = has_next ? (const char*)g.Bt + (size_t)nxt.pn * tstepB : cB;
        for (int t = 0; t < nt; t += 2) {
            const bool last = (t == nt - 2);
            const char* a1 = cA + (size_t)(t + 1) * kstep;
            const char* a2 = last ? nA : cA + (size_t)(t + 2) * kstep; const char* b2 = last ? nB : cB + (size_t)(t + 2) * kstep;
            const char* a3 = a2 + kstep; const char* b3 = b2 + kstep;
            if constexpr (Epi::HAS_MID) { if (t == nt / 2) E.mid(acc, cur, wr, wc, fr, fq); }
            if (last && has_next) S.a_ready(nxt);
            if constexpr (SP2) {
            PG8_LDB(B0, 0, 0); PG8_LDB(B1, 0, 1); PG8_SCHED; PG8_LDA(At, 0, 0); PG8_STAGE(PG8_SA(1, 1), a1 + hstepA, voffA);
            PG8_WAIT_V(8); PG8_WAIT_L(0); PG8_BAR; PG8_MMA(0, 0, At, B0); PG8_MMA(0, 1, At, B1); PG8_BAR; PG8_SCHED;
            PG8_LDA(At, 0, 1); PG8_STAGE(PG8_SB(0, 0), b2, voffB); PG8_STAGE(PG8_SB(0, 1), b2 + hstepB, voffB); PG8_STAGE(PG8_SA(0, 0), a2, voffA);
            PG8_WAIT_V(8); PG8_WAIT_L(0); PG8_BAR; PG8_MMA(1, 0, At, B0); PG8_MMA(1, 1, At, B1); PG8_BAR; PG8_SCHED;
            PG8_LDB(B0, 1, 0); PG8_LDB(B1, 1, 1); PG8_SCHED; PG8_LDA(At, 1, 0); PG8_STAGE(PG8_SA(0, 1), a2 + hstepA, voffA);
            PG8_WAIT_V(8); PG8_WAIT_L(0); PG8_BAR; PG8_MMA(0, 0, At, B0); PG8_MMA(0, 1, At, B1); PG8_BAR; PG8_SCHED;
            PG8_LDA(At, 1, 1); PG8_STAGE(PG8_SB(1, 0), b3, voffB); PG8_STAGE(PG8_SB(1, 1), b3 + hstepB, voffB); PG8_STAGE(PG8_SA(1, 0), a3, voffA);
            PG8_WAIT_V(8); PG8_WAIT_L(0); PG8_BAR; PG8_MMA(1, 0, At, B0); PG8_MMA(1, 1, At, B1); PG8_BAR; PG8_SCHED;
            } else {
            PG8_LDB(B0, 0, 0); PG8_SCHED; PG8_LDA(At, 0, 0); PG8_STAGE(PG8_SA(1, 1), a1 + hstepA, voffA);
            PG8_WAIT_L(8); PG8_BAR; PG8_WAIT_L(0); PG8_MMA(0, 0, At, B0); PG8_BAR; PG8_SCHED;
            PG8_LDB(B1, 0, 1); PG8_STAGE(PG8_SB(0, 0), b2, voffB);
            PG8_BAR; PG8_WAIT_L(0); PG8_MMA(0, 1, At, B1); PG8_BAR;
            PG8_LDA(At, 0, 1); PG8_STAGE(PG8_SA(0, 0), a2, voffA);
            PG8_BAR; PG8_WAIT_L(0); PG8_MMA(1, 0, At, B0); PG8_BAR; PG8_SCHED;
            PG8_STAGE(PG8_SB(0, 1), b2 + hstepB, voffB);
            PG8_WAIT_V(6); PG8_BAR; PG8_MMA(1, 1, At, B1); PG8_BAR;
            PG8_LDB(B0, 1, 0); PG8_SCHED; PG8_LDA(At, 1, 0); PG8_STAGE(PG8_SA(0, 1), a2 + hstepA, voffA);
            PG8_WAIT_L(8); PG8_BAR; PG8_WAIT_L(0); PG8_MMA(0, 0, At, B0); PG8_BAR; PG8_SCHED;
            PG8_LDB(B1, 1, 1); PG8_STAGE(PG8_SB(1, 0), b3, voffB);
            PG8_BAR; PG8_WAIT_L(0); PG8_MMA(0, 1, At, B1); PG8_BAR;
            PG8_LDA(At, 1, 1); PG8_STAGE(PG8_SA(1, 0), a3, voffA);
            PG8_BAR; PG8_WAIT_L(0); PG8_MMA(1, 0, At, B0); PG8_BAR; PG8_SCHED;
            PG8_STAGE(PG8_SB(1, 1), b3 + hstepB, voffB);
            PG8_WAIT_V(6); PG8_BAR; PG8_MMA(1, 1, At, B1); PG8_BAR;
            }
        }
        if constexpr (ALIGN_EPI) { if (wr == 0) PG8_BAR; }
        if constexpr (!Epi::AFTER_DRAIN) { E(acc, cur, wr, wc, fr, fq); S.done(cur); }
        if (!has_next) break;
#pragma unroll
        for (int a = 0; a < 2; ++a)
#pragma unroll
            for (int b = 0; b < 2; ++b)
#pragma unroll
                for (int m = 0; m < 4; ++m)
#pragma unroll
                    for (int n = 0; n < 2; ++n) acc[a][b][m][n] = (f32x4){0.f, 0.f, 0.f, 0.f};
        cur = nxt; cA = nA; cB = nB; ++ui;
        if constexpr (ALIGN_EPI) { if (wr == 1) PG8_BAR; }
    }
    PG8_WAIT_V(0);
    if constexpr (!ALIGN_EPI) { if (wr == 0) PG8_BAR; }
    PG8_BAR;
    if constexpr (Epi::AFTER_DRAIN) { E.fused(acc, cur, wr, wc, fr, fq, lds, wid, lane); S.done(cur); }
#undef PG8_SA
#undef PG8_SB
#undef PG8_STAGE
#undef PG8_LDA
#undef PG8_LDB
#undef PG8_MMA
#undef PG8_WAIT_V
#undef PG8_WAIT_L
#undef PG8_BAR
#undef PG8_SCHED
}
}
#define XB_TMO      128
#define XB_XCNT(j)  (256  + 64 * (j))
#define XB_XSUB(j)  (1280 + 64 * (j))
#define XB_XGEN(j)  (2304 + 64 * (j))
#define XB_TOP      3328
#define XB_TOPGEN   3392
#define XCD_BAR_WORDS 3456
#define XB_SPIN_CAP (1u << 18)

__device__ __forceinline__ unsigned xb_ld(unsigned* p)              { return __hip_atomic_load(p, __ATOMIC_RELAXED, __HIP_MEMORY_SCOPE_AGENT); }
__device__ __forceinline__ unsigned xb_add(unsigned* p, unsigned v) { return __hip_atomic_fetch_add(p, v, __ATOMIC_RELAXED, __HIP_MEMORY_SCOPE_AGENT); }
__device__ __forceinline__ unsigned xb_xcc_id() { return (unsigned)__builtin_amdgcn_s_getreg((3 << 11) | 20) & 0xFu; }
#define XB_SPIN(cond, bar) do { unsigned _sp = 0; while (cond) { __builtin_amdgcn_s_sleep(1); \
    if ((++_sp & 255u) == 0u) { if (xb_ld(&(bar)[XB_TMO])) break; if (_sp > XB_SPIN_CAP) { atomicAdd(&(bar)[XB_TMO], 1u); break; } } } } while (0)

struct XcdBarrier {
    unsigned* bar; unsigned x;
    volatile LAS unsigned* st;
};

__device__ __forceinline__ XcdBarrier xcd_barrier_post(unsigned* bar, volatile LAS unsigned* st) {
    XcdBarrier b; b.bar = bar; b.x = xb_xcc_id(); b.st = st;
    if (threadIdx.x == 0) (void)xb_add(&bar[XB_XCNT(b.x)], 1u);
    return b;
}
__device__ __forceinline__ void xcd_barrier_complete(unsigned* bar, unsigned x, unsigned& nloc, unsigned& nx) {
    const unsigned G = gridDim.x * gridDim.y * gridDim.z;
    unsigned sum, cnt, mine, sp = 0u;
    for (;;) {
        sum = 0u; cnt = 0u; mine = 0u;
#pragma unroll
        for (unsigned j = 0; j < 16; ++j) { const unsigned c = xb_ld(&bar[XB_XCNT(j)]); sum += c; cnt += (c > 0u) ? 1u : 0u; mine = (j == x) ? c : mine; }
        if (sum == G) break;
        __builtin_amdgcn_s_sleep(1);
        if ((++sp & 255u) == 0u) { if (xb_ld(&bar[XB_TMO])) break; if (sp > XB_SPIN_CAP) { atomicAdd(&bar[XB_TMO], 1u); break; } }
    }
    nloc = mine > 0u ? mine : 1u; nx = cnt > 0u ? cnt : 1u;
}

__device__ __forceinline__ void xcd_barrier(const XcdBarrier& b) {
    asm volatile("s_waitcnt vmcnt(0)" ::: "memory");
    __syncthreads();
    if (threadIdx.x == 0) {
        unsigned* bar = b.bar;
        __builtin_amdgcn_s_waitcnt(0);
        unsigned nloc = b.st[0], nx = b.st[1];
        if (nloc == 0u) { xcd_barrier_complete(bar, b.x, nloc, nx); b.st[0] = nloc; b.st[1] = nx; }
        const unsigned old = xb_add(&bar[XB_XSUB(b.x)], 1u);
        const unsigned gen = old / nloc;
        if (old + 1u == (gen + 1u) * nloc) {
            __builtin_amdgcn_fence(__ATOMIC_RELEASE, "agent");
            asm volatile("s_waitcnt vmcnt(0)" ::: "memory");
            const unsigned og = xb_add(&bar[XB_TOP], 1u);
            const unsigned tg = og / nx;
            if (og + 1u == (tg + 1u) * nx) xb_add(&bar[XB_TOPGEN], 1u);
            else XB_SPIN(xb_ld(&bar[XB_TOPGEN]) == tg, bar);
            __builtin_amdgcn_fence(__ATOMIC_ACQUIRE, "agent");
            xb_add(&bar[XB_XGEN(b.x)], 1u);
            asm volatile("s_waitcnt vmcnt(0)" ::: "memory");
        } else {
            XB_SPIN(xb_ld(&bar[XB_XGEN(b.x)]) == gen, bar);
            __builtin_amdgcn_fence(__ATOMIC_ACQUIRE, "agent");
            asm volatile("s_waitcnt vmcnt(0)" ::: "memory");
        }
    }
    __syncthreads();
}
#ifndef MK_N_LAUNCHES
#define MK_N_LAUNCHES 1
#endif
constexpr int NWAVES = 8, NTHR = 512;
constexpr int D = 4096, BATCH = 2, T = 8192, LC = 256;
constexpr int M_LAT = BATCH * T, M_CTX = BATCH * LC, M_ALL = M_LAT + M_CTX;
constexpr int C = 2048, NH = 32, HS = 64;
constexpr int NRW = 6784, NRWP = 6912, NQKV = 3072, NGATE = 8192, N_IN = 18048, N_INP = NRWP + NQKV + NGATE;
constexpr int DFF = 11008;
constexpr int NMOD = 6 * D;
constexpr float LN_EPS = 1e-5f, GN_EPS = 64e-5f, ALPHA = 1.189207115002721f;
constexpr int NPHASE = 15;
#ifndef REPMASK
#define REPMASK 0
#endif

constexpr size_t MiB = 1u << 20;
constexpr size_t WS_CTL = 0, CTL_ZERO_BYTES = 64 * 1024;
constexpr size_t WS_MOD = 256 * 1024;
constexpr size_t WS_MODP = 1 * MiB;
constexpr size_t WS_WOCAT = 8 * MiB, WS_WOUT = 40 * MiB;
constexpr size_t WS_W1 = 72 * MiB;
constexpr size_t WS_H = 214 * MiB;
constexpr size_t WS_IPRW = 346 * MiB;
constexpr size_t WS_IPQKV = 569 * MiB;
constexpr size_t WS_IPGATE = 668 * MiB;
constexpr size_t WS_R = 72 * MiB, WS_K = 138 * MiB, WS_V = 204 * MiB;
constexpr size_t WS_INVN = 270 * MiB;
constexpr size_t WS_BONUS = 1 * MiB;
constexpr size_t WS_G = 273 * MiB;
constexpr size_t WS_MA = 924 * MiB;
constexpr size_t WS_ROPE = 924 * MiB;
constexpr size_t WS_ICLR = 1052 * MiB;
constexpr size_t WS_DEC = 1184 * MiB;
constexpr size_t WS_WGU = 346 * MiB;
constexpr size_t WS_WDN = 1448 * MiB;
constexpr size_t WS_TMP = 72 * MiB;
constexpr size_t WS_MERGED = 1052 * MiB;
constexpr size_t WS_X1 = 72 * MiB;
constexpr size_t WS_H2 = 1180 * MiB;
constexpr size_t WS_ACT = 668 * MiB;
constexpr size_t WS_LORAT = 5 * MiB + 512 * 1024;
constexpr size_t WS_END = 1534 * MiB;
constexpr int CW_BAR = 4096;
static_assert((CW_BAR + 3456) * 4 <= (int)CTL_ZERO_BYTES, "ctl");

constexpr int RING_OFF = 0, RING_BYTES = 131072;
constexpr int LDS_BYTES = 163840;
constexpr int LDSCTL_OFF = LDS_BYTES - 512, MISC_OFF = LDSCTL_OFF + 320;

#define GAS __attribute__((address_space(1)))
typedef unsigned short bf16;
typedef unsigned v4u __attribute__((ext_vector_type(4)));
typedef unsigned v2u __attribute__((ext_vector_type(2)));
typedef float f32x4 __attribute__((ext_vector_type(4)));
typedef float f32x2 __attribute__((ext_vector_type(2)));
typedef short bf16x8 __attribute__((ext_vector_type(8)));
typedef short bf16x4 __attribute__((ext_vector_type(4)));
typedef short s16x4 __attribute__((ext_vector_type(4)));
#define LDS_WAIT() asm volatile("s_waitcnt lgkmcnt(0)" ::: "memory")
#define VM_WAIT() asm volatile("s_waitcnt vmcnt(0)" ::: "memory")
__device__ __forceinline__ unsigned f2bf(float f) { unsigned u = __float_as_uint(f); return (u + 0x7fffu + ((u >> 16) & 1u)) >> 16; }
__device__ __forceinline__ unsigned pk2(float lo, float hi) { return pg8::cvt_pk_bf16(lo, hi); }
__device__ __forceinline__ float bf2f(bf16 v) { return __uint_as_float((unsigned)v << 16); }
__device__ __forceinline__ float bflo(unsigned w) { return __uint_as_float(w << 16); }
__device__ __forceinline__ float bfhi(unsigned w) { return __uint_as_float(w & 0xffff0000u); }
__device__ __forceinline__ float sigmf(float x) { return __builtin_amdgcn_rcpf(1.0f + __expf(-x)); }
template <int CTRL> __device__ __forceinline__ float dpp_mov(float v) { return __int_as_float(__builtin_amdgcn_update_dpp(0, __float_as_int(v), CTRL, 0xF, 0xF, true)); }
__device__ __forceinline__ float rows_sum(float v) {
    auto a = __builtin_amdgcn_permlane16_swap(__float_as_uint(v), __float_as_uint(v), false, false); v = __uint_as_float(a[0]) + __uint_as_float(a[1]);
    auto b = __builtin_amdgcn_permlane32_swap(__float_as_uint(v), __float_as_uint(v), false, false); return __uint_as_float(b[0]) + __uint_as_float(b[1]);
}
__device__ __forceinline__ float rows_max(float v) {
    auto a = __builtin_amdgcn_permlane16_swap(__float_as_uint(v), __float_as_uint(v), false, false); v = fmaxf(__uint_as_float(a[0]), __uint_as_float(a[1]));
    auto b = __builtin_amdgcn_permlane32_swap(__float_as_uint(v), __float_as_uint(v), false, false); return fmaxf(__uint_as_float(b[0]), __uint_as_float(b[1]));
}
__device__ __forceinline__ float wave_sum(float v) {
    v += dpp_mov<0xB1>(v);
    v += dpp_mov<0x4E>(v);
    v += dpp_mov<0x141>(v);
    v += dpp_mov<0x140>(v);
    const int b = __float_as_int(v);
    return (__int_as_float(__builtin_amdgcn_readlane(b, 0)) + __int_as_float(__builtin_amdgcn_readlane(b, 16))) + (__int_as_float(__builtin_amdgcn_readlane(b, 32)) + __int_as_float(__builtin_amdgcn_readlane(b, 48)));
}

struct Frame {
    LAS unsigned char* lds;
    int tid, lane, wave, G, blk;
    const float* in[29]; float* out; unsigned char* ws;
};
enum { I_X = 0, I_C, I_CTX, I_CCTX, I_WADA, I_BADA, I_WIN, I_SHIFT, I_W0, I_WUP, I_A0, I_AUP, I_GUP, I_KK, I_KA, I_RK, I_GNG, I_GNB, I_SINK, I_WRO, I_WAO, I_WOUT, I_LN1G, I_LN1B, I_WFG, I_WFU, I_WFD, I_LN2G, I_LN2B };

struct TItem { const float* src; bf16* dst; int N, ldk, rp; };
__device__ __forceinline__ void t_load(const TItem& t, f32x4 (&v)[8], int lane) {
#pragma unroll
    for (int i = 0; i < 8; ++i) v[i] = *(const f32x4*)(t.src + (size_t)(8 * i + (lane >> 3)) * t.N + 4 * (lane & 7));
}
__device__ __forceinline__ void t_store(const TItem& t, const f32x4 (&v)[8], LAS float* scr, int lane) {
#pragma unroll
    for (int i = 0; i < 8; ++i) { LAS float* p = scr + (8 * i + (lane >> 3)) * 33 + 4 * (lane & 7); p[0] = v[i][0]; p[1] = v[i][1]; p[2] = v[i][2]; p[3] = v[i][3]; }
    LDS_WAIT(); asm volatile("" ::: "memory");
    const int c = lane & 7;
#pragma unroll
    for (int j = 0; j < 4; ++j) { const int n = (lane >> 3) + 8 * j; const LAS float* s = scr + (8 * c) * 33 + n;
        v4u o; o.x = pk2(s[0 * 33], s[1 * 33]); o.y = pk2(s[2 * 33], s[3 * 33]); o.z = pk2(s[4 * 33], s[5 * 33]); o.w = pk2(s[6 * 33], s[7 * 33]);
        const int nr = t.rp ? 8 * (n >> 2) + (n & 3) : n;
        *(v4u*)(t.dst + (size_t)nr * t.ldk + 8 * c) = o; }
    LDS_WAIT(); asm volatile("" ::: "memory");
}
__device__ __forceinline__ TItem t_make(const float* W, int N, bf16* WT, size_t drow, int ldk, int koff, int k0, int n0) { TItem t; t.src = W + (size_t)k0 * N + n0; t.dst = WT + drow * (size_t)ldk + koff + k0; t.N = N; t.ldk = ldk; t.rp = 0; return t; }
#define T_PIPELINE(NITEMS_, DECODE_) do { int it_ = gw; if (it_ < (NITEMS_)) { TItem cur_ = DECODE_(it_); f32x4 v_[8]; t_load(cur_, v_, F.lane); \
        for (;;) { const int nx_ = it_ + NGW; const bool has_ = nx_ < (NITEMS_); TItem nxt_ = cur_; f32x4 vn_[8]; \
            if (has_) { nxt_ = DECODE_(nx_); t_load(nxt_, vn_, F.lane); } else { _Pragma("unroll") for (int i_ = 0; i_ < 8; ++i_) vn_[i_] = (f32x4){0.f, 0.f, 0.f, 0.f}; } \
            t_store(cur_, v_, scr, F.lane); if (!has_) break; cur_ = nxt_; it_ = nx_; _Pragma("unroll") for (int i_ = 0; i_ < 8; ++i_) v_[i_] = vn_[i_]; } } } while (0)
__device__ __forceinline__ void p0_convert_a(Frame& F) {
    LAS float* scr = (LAS float*)(F.lds + RING_OFF + F.wave * 16384);
    const int gw = F.blk * NWAVES + F.wave, NGW = F.G * NWAVES;
    bf16* W1 = (bf16*)(F.ws + WS_W1); bf16* WOC = (bf16*)(F.ws + WS_WOCAT); bf16* WOUT = (bf16*)(F.ws + WS_WOUT); bf16* LT = (bf16*)(F.ws + WS_LORAT);
    constexpr int I_IN = (D / 64) * (N_IN / 32), I_RO = (C / 64) * (D / 32), I_OUT = (D / 64) * (D / 32);
    constexpr int I_LW = 3 * (C / 32), I_LG = 4 * (C / 32);
    constexpr int NITEMS = I_IN + 2 * I_LW + I_LG;
    auto decode = [&](int it) -> TItem {
        int r = it;
        if (r < I_IN) { const int nb = r % (N_IN / 32), kb = r / (N_IN / 32), n0 = 32 * nb;
            if (n0 >= NRW && n0 < NRW + 2560) {
                const int hd = (n0 - NRW) >> 7, d0 = (n0 - NRW) & 127; TItem t = t_make(F.in[I_WIN], N_IN, W1, (size_t)(NRWP + hd * 128 + 8 * ((d0 & 63) >> 2) + (d0 >= 64 ? 4 : 0)), D, 0, 64 * kb, n0); t.rp = 1; return t; }
            return t_make(F.in[I_WIN], N_IN, W1, (size_t)(n0 + (n0 >= NRW ? NRWP - NRW : 0)), D, 0, 64 * kb, n0); } r -= I_IN;
        if (r < I_LW) { const int nb = r % (C / 32), kb = r / (C / 32); return t_make(F.in[I_WUP], C, LT, (size_t)(32 * nb), 640, 0, 64 * kb, 32 * nb); } r -= I_LW;
        if (r < I_LW) { const int nb = r % (C / 32), kb = r / (C / 32); return t_make(F.in[I_AUP], C, LT, (size_t)(32 * nb), 640, 192, 64 * kb, 32 * nb); } r -= I_LW;
        { const int nb = r % (C / 32), kb = r / (C / 32); return t_make(F.in[I_GUP], C, LT, (size_t)(32 * nb), 640, 384, 64 * kb, 32 * nb); }
    };
    T_PIPELINE(NITEMS, decode);
    { float* RC = (float*)(F.ws + WS_ROPE); float* RS = RC + T * 64;
      for (int i = F.blk * NTHR + F.tid; i < T * 64; i += F.G * NTHR) { const int t = i >> 6, p = i & 63;
          const float inv = exp2f(-(float)(p & 31) * (13.287712379549449f / 32.0f)), ang = (p < 32 ? (float)(t >> 6) : (float)(t & 63)) * inv; RC[i] = cosf(ang); RS[i] = sinf(ang); } }
    { v4u z = {0u, 0u, 0u, 0u}; v4u* p = (v4u*)(W1 + (size_t)NRW * D); const int n16 = (NRWP - NRW) * D / 8;
      for (int i = F.blk * NTHR + F.tid; i < n16; i += F.G * NTHR) p[i] = z; }
    float* MODP = (float*)(F.ws + WS_MODP);
    const float* wada = F.in[I_WADA];
    for (int task = gw; task < 96 * 16; task += NGW) {
        const int cg = task % 96, ks = task / 96, col = cg * 256 + F.lane * 4;
        f32x4 a0 = {0.f, 0.f, 0.f, 0.f}, a1 = a0, a2 = a0;
        const float* c0 = F.in[I_C] + ks * 256; const float* c1 = F.in[I_C] + D + ks * 256; const float* c2 = F.in[I_CCTX] + ks * 256;
#pragma unroll 4
        for (int k = 0; k < 256; ++k) {
            const f32x4 w = *(const f32x4*)(wada + (size_t)(ks * 256 + k) * NMOD + col);
            const float x0 = c0[k], x1 = c1[k], x2 = c2[k];
            a0 += w * (x0 * sigmf(x0)); a1 += w * (x1 * sigmf(x1)); a2 += w * (x2 * sigmf(x2));
        }
        float* o = MODP + (size_t)ks * 3 * NMOD + col;
        *(f32x4*)o = a0; *(f32x4*)(o + NMOD) = a1; *(f32x4*)(o + 2 * NMOD) = a2;
    }
}
constexpr int FFN_ID0 = 86 * (D / 32);
__device__ __forceinline__ void p_convert_ffn(Frame& F, int wg0, int nwg, int part) {
    LAS float* scr = (LAS float*)(F.lds + RING_OFF + F.wave * 16384);
    const int gw = (F.blk - wg0) * NWAVES + F.wave, NGW = nwg * NWAVES;
    bf16* WGU = (bf16*)(F.ws + WS_WGU); bf16* WDN = (bf16*)(F.ws + WS_WDN);
    constexpr int I_G = (D / 64) * (DFF / 32), I_D = (DFF / 64) * (D / 32);
    constexpr int I_OUT = (D / 64) * (D / 32), I_RO = (C / 64) * (D / 32); bf16* WOUT = (bf16*)(F.ws + WS_WOUT); bf16* WOC = (bf16*)(F.ws + WS_WOCAT);
    const int NITEMS = part == 0 ? 2 * I_RO + I_OUT + 2 * I_G + FFN_ID0 : I_D - FFN_ID0;
    auto decode = [&](int it) -> TItem {
        int r = part == 0 ? it : it + 2 * I_RO + I_OUT + 2 * I_G + FFN_ID0;
        if (r < I_RO) { const int nb = r % (D / 32), kb = r / (D / 32); return t_make(F.in[I_WRO], D, WOC, (size_t)(32 * nb), D, 0, 64 * kb, 32 * nb); } r -= I_RO;
        if (r < I_RO) { const int nb = r % (D / 32), kb = r / (D / 32); return t_make(F.in[I_WAO], D, WOC, (size_t)(32 * nb), D, C, 64 * kb, 32 * nb); } r -= I_RO;
        if (r < I_OUT) { const int nb = r % (D / 32), kb = r / (D / 32); return t_make(F.in[I_WOUT], D, WOUT, (size_t)(32 * nb), D, 0, 64 * kb, 32 * nb); } r -= I_OUT;
        if (r < I_G) { const int nb = r % (DFF / 32), kb = r / (DFF / 32), n0 = 32 * nb; return t_make(F.in[I_WFG], DFF, WGU, (size_t)((n0 >> 7) * 256 + (n0 & 127)), D, 0, 64 * kb, n0); } r -= I_G;
        if (r < I_G) { const int nb = r % (DFF / 32), kb = r / (DFF / 32), n0 = 32 * nb; return t_make(F.in[I_WFU], DFF, WGU, (size_t)((n0 >> 7) * 256 + 128 + (n0 & 127)), D, 0, 64 * kb, n0); } r -= I_G;
        { const int nb = r % (D / 32), kb = r / (D / 32); return t_make(F.in[I_WFD], D, WDN, (size_t)(32 * nb), DFF, 0, 64 * kb, 32 * nb); }
    };
    T_PIPELINE(NITEMS, decode);
}
__device__ __forceinline__ void p1_mod(Frame& F) {
    const float* MODP = (const float*)(F.ws + WS_MODP); float* MOD = (float*)(F.ws + WS_MOD); const float* bada = F.in[I_BADA];
    for (int i = F.blk * NTHR + F.tid; i < 3 * NMOD; i += F.G * NTHR) {
        float s = bada[i % NMOD];
#pragma unroll
        for (int ks = 0; ks < 16; ++ks) s += MODP[(size_t)ks * 3 * NMOD + i];
        MOD[i] = s;
    }
}
__device__ __forceinline__ void p2_modulate(Frame& F) {
    const int gw = F.blk * NWAVES + F.wave, NGW = F.G * NWAVES;
    const float* MOD = (const float*)(F.ws + WS_MOD); bf16* H = (bf16*)(F.ws + WS_H);
    for (int m = gw; m < M_ALL; m += NGW) {
        const int b = m < M_LAT ? (m >> 13) : 2;
        const float* src = m < M_LAT ? F.in[I_X] + (size_t)m * D : F.in[I_CTX] + (size_t)(m - M_LAT) * D;
        const float* sh = MOD + (size_t)b * NMOD; const float* sc = sh + D;
        v2u* o = (v2u*)(H + (size_t)m * D);
#pragma unroll 8
        for (int j = 0; j < 16; ++j) { const int c = 4 * F.lane + 256 * j;
            const f32x4 v = *(const f32x4*)(src + c), s = *(const f32x4*)(sc + c), h = *(const f32x4*)(sh + c);
            const f32x4 r = v * (s + 1.0f) + h; v2u w; w.x = pk2(r[0], r[1]); w.y = pk2(r[2], r[3]); o[F.lane + 64 * j] = w; }
    }
}

constexpr int ACT_PITCH = 648;
constexpr int FTOK = 32;
template <int PART> __device__ __forceinline__ void p4_features_mfma(Frame& F, const int wg0, const int nwg) {
    LAS bf16* act = (LAS bf16*)(F.lds + RING_OFF);
    const bf16* IPRW = (const bf16*)(F.ws + WS_IPRW);
    const float* shw = F.in[I_SHIFT];
    bf16* Rb = (bf16*)(F.ws + WS_R); bf16* Kb = (bf16*)(F.ws + WS_K); bf16* Vb = (bf16*)(F.ws + WS_V);
    bf16* ICL = (bf16*)(F.ws + WS_ICLR); bf16* DEC = (bf16*)(F.ws + WS_DEC); float* INVN = (float*)(F.ws + WS_INVN); bf16* Gb = (bf16*)(F.ws + WS_G);
    const bf16* LT = (const bf16*)(F.ws + WS_LORAT); float* BON = (float*)(F.ws + WS_BONUS);
    constexpr int NITEM = ((PART ? M_LAT : M_ALL) / FTOK) * 4;
    const int i0 = (int)(((long)(F.blk - wg0) * NITEM) / nwg), i1 = (int)(((long)(F.blk - wg0 + 1) * NITEM) / nwg);
    for (int item = i0; item < i1; ++item) {
        int lane_o = F.lane; asm volatile("" : "+v"(lane_o)); const int lane = lane_o, l16 = lane & 15, gq = lane >> 4;
        const int tile = item >> 2, q = item & 3, m0 = tile * FTOK, head = q * 8 + F.wave, chb = head * 64;
        int s0, s1;
        if (m0 < M_LAT) { s0 = (m0 >> 13) << 13; s1 = s0 + T; } else { s0 = M_LAT + (((m0 - M_LAT) >> 8) << 8); s1 = s0 + LC; }
        if (item == i0 || q == 0) {
            __syncthreads();
#pragma unroll 1
            for (int cj = (PART ? 384 : 0) + F.tid; cj < (PART ? 640 : 384); cj += NTHR) {
                const int c = 6144 + cj; const float sa = shw[c], sb = shw[NRW + c], sc = shw[2 * NRW + c];
                float xr[FTOK + 2];
#pragma unroll
                for (int i = 0; i < FTOK + 2; ++i) { const int mm = m0 - 1 + i; xr[i] = (mm >= s0 && mm < s1) ? bf2f(IPRW[(size_t)mm * NRWP + c]) : 0.f; }
#pragma unroll
                for (int tt = 0; tt < FTOK; ++tt) { float v = xr[tt] * sa + xr[tt + 1] * sb + xr[tt + 2] * sc;
                    if (cj < 192) v = 1.0f - 2.0f * __builtin_amdgcn_rcpf(1.0f + __expf(2.0f * v)); else if (cj >= 384) v = sigmf(v);
                    act[tt * ACT_PITCH + cj] = (bf16)f2bf(v); }
            }
            __syncthreads();
        }
        const bf16* wrow = LT + (size_t)(chb + 16 * (l16 >> 2) + (l16 & 3)) * 640 + 8 * gq;
        const LAS bf16* arow = act + l16 * ACT_PITCH + 8 * gq;
        const int cl = chb + 16 * gq;
        const bool lat = m0 < M_LAT;
        bf16x8 wcur[4][4], wnxt[4][4];
#pragma unroll
        for (int ks = 0; ks < 4; ++ks)
#pragma unroll
            for (int nt = 0; nt < 4; ++nt) { wcur[ks][nt] = (bf16x8){0, 0, 0, 0, 0, 0, 0, 0}; wnxt[ks][nt] = wcur[ks][nt]; }
#pragma unroll
        for (int ks = 0; ks < (PART ? 4 : 3); ++ks)
#pragma unroll
            for (int nt = 0; nt < 4; ++nt) wcur[ks][nt] = *(const bf16x8*)(wrow + (size_t)nt * 4 * 640 + (PART ? 384 : 0) + ks * 32);
        f32x4 acc[2][4];
#pragma unroll
        for (int s = (PART ? 4 : 0); s < (PART ? 6 : 4); ++s) {
            const int k0 = s < 4 ? s * 96 : 384 + (s - 4) * 128, nks = s < 4 ? 3 : 4;
            if (s + 1 < (PART ? 6 : 4)) { const int k1 = (s + 1) < 4 ? (s + 1) * 96 : 384 + (s + 1 - 4) * 128, nk1 = (s + 1) < 4 ? 3 : 4;
#pragma unroll
                for (int ks = 0; ks < 4; ++ks) if (ks < nk1) {
#pragma unroll
                    for (int nt = 0; nt < 4; ++nt) wnxt[ks][nt] = *(const bf16x8*)(wrow + (size_t)nt * 4 * 640 + k1 + ks * 32); } }
            if (s < 4 || lat) {
                if (s != 5) {
#pragma unroll
                    for (int tt = 0; tt < 2; ++tt)
#pragma unroll
                        for (int nt = 0; nt < 4; ++nt) acc[tt][nt] = (f32x4){0.f, 0.f, 0.f, 0.f}; }
#pragma unroll
                for (int ks = 0; ks < 4; ++ks) if (ks < nks) { const int k = k0 + ks * 32;
                    const bf16x8 af0 = *(const LAS bf16x8*)(arow + k), af1 = *(const LAS bf16x8*)(arow + 16 * ACT_PITCH + k);
#pragma unroll
                    for (int nt = 0; nt < 4; ++nt) { acc[0][nt] = __builtin_amdgcn_mfma_f32_16x16x32_bf16(wcur[ks][nt], af0, acc[0][nt], 0, 0, 0); acc[1][nt] = __builtin_amdgcn_mfma_f32_16x16x32_bf16(wcur[ks][nt], af1, acc[1][nt], 0, 0, 0); } }
                if (s < 4) {
                    const float* bias = (s < 2 ? F.in[I_W0] : F.in[I_A0]) + (s & 1) * C + cl;
                    f32x4 bv[4];
#pragma unroll
                    for (int nt = 0; nt < 4; ++nt) bv[nt] = *(const f32x4*)(bias + 4 * nt);
#pragma unroll
                    for (int tt = 0; tt < 2; ++tt) { const size_t o = (size_t)(m0 + tt * 16 + l16) * C + cl; f32x4 sg[4];
#pragma unroll
                        for (int nt = 0; nt < 4; ++nt) { const f32x4 z = acc[tt][nt] + bv[nt];
#pragma unroll
                            for (int e = 0; e < 4; ++e) sg[nt][e] = sigmf(z[e]); }
                        if (s < 2) { v4u w0, w1; const float ce = 0.6065306597126334f;
                            w0.x = pk2(ce * sg[0][0], ce * sg[0][1]); w0.y = pk2(ce * sg[0][2], ce * sg[0][3]); w0.z = pk2(ce * sg[1][0], ce * sg[1][1]); w0.w = pk2(ce * sg[1][2], ce * sg[1][3]);
                            w1.x = pk2(ce * sg[2][0], ce * sg[2][1]); w1.y = pk2(ce * sg[2][2], ce * sg[2][3]); w1.z = pk2(ce * sg[3][0], ce * sg[3][1]); w1.w = pk2(ce * sg[3][2], ce * sg[3][3]);
                            bf16* p = DEC + (size_t)s * M_ALL * C + o; *(v4u*)p = w0; *(v4u*)(p + 8) = w1; }
                        else { v4u w0, w1; w0.x = pk2(sg[0][0], sg[0][1]); w0.y = pk2(sg[0][2], sg[0][3]); w0.z = pk2(sg[1][0], sg[1][1]); w0.w = pk2(sg[1][2], sg[1][3]);
                            w1.x = pk2(sg[2][0], sg[2][1]); w1.y = pk2(sg[2][2], sg[2][3]); w1.z = pk2(sg[3][0], sg[3][1]); w1.w = pk2(sg[3][2], sg[3][3]);
                            bf16* p = ICL + (size_t)(s - 2) * M_ALL * C + o; *(v4u*)p = w0; *(v4u*)(p + 8) = w1; } }
                } else if (s == 5) {
#pragma unroll
                    for (int tt = 0; tt < 2; ++tt) { const size_t o = (size_t)(m0 + tt * 16 + l16) * C + cl; v4u w0, w1;
                        w0.x = pk2(acc[tt][0][0], acc[tt][0][1]); w0.y = pk2(acc[tt][0][2], acc[tt][0][3]); w0.z = pk2(acc[tt][1][0], acc[tt][1][1]); w0.w = pk2(acc[tt][1][2], acc[tt][1][3]);
                        w1.x = pk2(acc[tt][2][0], acc[tt][2][1]); w1.y = pk2(acc[tt][2][2], acc[tt][2][3]); w1.z = pk2(acc[tt][3][0], acc[tt][3][1]); w1.w = pk2(acc[tt][3][2], acc[tt][3][3]);
                        *(v4u*)(Gb + o) = w0; *(v4u*)(Gb + o + 8) = w1; }
                }
            }
#pragma unroll
            for (int ks = 0; ks < 4; ++ks)
#pragma unroll
                for (int nt = 0; nt < 4; ++nt) wcur[ks][nt] = wnxt[ks][nt];
        }
#pragma unroll 1
        for (int tt = 0; tt < (PART ? 0 : 2); ++tt) {
            const int m = m0 + tt * 16 + l16; const bool hm = (m - 1 >= s0), hp = (m + 1 < s1);
            const size_t o = (size_t)m * C + cl; const bf16* p0 = IPRW + (size_t)m * NRWP + cl;
            float nrm = 0.f, bon = 0.f; f32x4 rk4[4];
#pragma unroll
            for (int x = 0; x < 3; ++x) {
                v4u outw[2];
#pragma unroll
                for (int hf = 0; hf < 2; ++hf) {
                    const v4u w0 = *(const v4u*)(p0 + x * C + 8 * hf), wm = hm ? *(const v4u*)(p0 + x * C - NRWP + 8 * hf) : (v4u){0u, 0u, 0u, 0u}, wp = hp ? *(const v4u*)(p0 + x * C + NRWP + 8 * hf) : (v4u){0u, 0u, 0u, 0u};
                    const int cc = x * C + cl + 8 * hf;
                    const f32x4 sa0 = *(const f32x4*)(shw + cc), sa1 = *(const f32x4*)(shw + cc + 4), sb0 = *(const f32x4*)(shw + NRW + cc), sb1 = *(const f32x4*)(shw + NRW + cc + 4), sc0 = *(const f32x4*)(shw + 2 * NRW + cc), sc1 = *(const f32x4*)(shw + 2 * NRW + cc + 4);
                    const f32x4 xm0 = {bflo(wm.x), bfhi(wm.x), bflo(wm.y), bfhi(wm.y)}, xm1 = {bflo(wm.z), bfhi(wm.z), bflo(wm.w), bfhi(wm.w)};
                    const f32x4 x00 = {bflo(w0.x), bfhi(w0.x), bflo(w0.y), bfhi(w0.y)}, x01 = {bflo(w0.z), bfhi(w0.z), bflo(w0.w), bfhi(w0.w)};
                    const f32x4 xp0 = {bflo(wp.x), bfhi(wp.x), bflo(wp.y), bfhi(wp.y)}, xp1 = {bflo(wp.z), bfhi(wp.z), bflo(wp.w), bfhi(wp.w)};
                    const f32x4 v0 = xm0 * sa0 + x00 * sb0 + xp0 * sc0, v1 = xm1 * sa1 + x01 * sb1 + xp1 * sc1;
                    outw[hf].x = pk2(v0[0], v0[1]); outw[hf].y = pk2(v0[2], v0[3]); outw[hf].z = pk2(v1[0], v1[1]); outw[hf].w = pk2(v1[2], v1[3]);
                    if (x == 0) { rk4[2 * hf] = v0; rk4[2 * hf + 1] = v1; }
                    if (x == 1) { rk4[2 * hf] = rk4[2 * hf] * v0 * *(const f32x4*)(F.in[I_RK] + cl + 8 * hf); rk4[2 * hf + 1] = rk4[2 * hf + 1] * v1 * *(const f32x4*)(F.in[I_RK] + cl + 8 * hf + 4); }
                    if (x == 1) { const f32x4 q0 = v0 * *(const f32x4*)(F.in[I_KK] + cl + 8 * hf), q1 = v1 * *(const f32x4*)(F.in[I_KK] + cl + 8 * hf + 4);
                        nrm += (q0[0] * q0[0] + q0[1] * q0[1]) + (q0[2] * q0[2] + q0[3] * q0[3]) + (q1[0] * q1[0] + q1[1] * q1[1]) + (q1[2] * q1[2] + q1[3] * q1[3]); }
                }
                bf16* dst = (x == 0 ? Rb : x == 1 ? Kb : Vb) + o; *(v4u*)dst = outw[0]; *(v4u*)(dst + 8) = outw[1];
            }
            {
                if (lat) {
                    const bf16* ia = ICL + o; const bf16* ib = ICL + (size_t)M_ALL * C + o;
#pragma unroll
                    for (int hf = 0; hf < 2; ++hf) { const v4u a = *(const v4u*)(ia + 8 * hf), b = *(const v4u*)(ib + 8 * hf);
                        const f32x4 ka0 = *(const f32x4*)(F.in[I_KA] + cl + 8 * hf), ka1 = *(const f32x4*)(F.in[I_KA] + cl + 8 * hf + 4);
                        const f32x4 s0 = {bflo(a.x) + bflo(b.x), bfhi(a.x) + bfhi(b.x), bflo(a.y) + bflo(b.y), bfhi(a.y) + bfhi(b.y)}, s1 = {bflo(a.z) + bflo(b.z), bfhi(a.z) + bfhi(b.z), bflo(a.w) + bflo(b.w), bfhi(a.w) + bfhi(b.w)};
                        const f32x4 t0 = rk4[2 * hf] * ((s0 - 2.0f) * ka0 + 2.0f), t1 = rk4[2 * hf + 1] * ((s1 - 2.0f) * ka1 + 2.0f);
                        bon += (t0[0] + t0[1]) + (t0[2] + t0[3]) + (t1[0] + t1[1]) + (t1[2] + t1[3]); }
                }
            }
            nrm = rows_sum(nrm); bon = rows_sum(bon);
            if (gq == 0) { INVN[(size_t)m * NH + head] = 1.0f / fmaxf(sqrtf(nrm), 1e-12f); if (lat) BON[(size_t)m * NH + head] = bon; }
        }
    }
}
__device__ __forceinline__ void p4_rope(Frame& F) {
    const int gw = F.blk * NWAVES + F.wave, NGW = F.G * NWAVES;
    bf16* QKV = (bf16*)(F.ws + WS_IPQKV);
    const int i0 = 4 * (F.lane & 15), hq = F.lane >> 4;
    float inv[4];
#pragma unroll
    for (int e = 0; e < 4; ++e) inv[e] = exp2f(-(float)((i0 + e) & 31) * (13.287712379549449f / 32.0f));
    for (int m = gw; m < M_LAT; m += NGW) {
        const int t = m & (T - 1); const float pos = (i0 < 32) ? (float)(t >> 6) : (float)(t & 63);
        float cs[4], sn[4];
#pragma unroll
        for (int e = 0; e < 4; ++e) { const float ang = pos * inv[e]; sn[e] = sinf(ang); cs[e] = cosf(ang); }
        bf16* row = QKV + (size_t)m * NQKV + i0;
        v2u a[5], bq[5];
#pragma unroll
        for (int j = 0; j < 5; ++j) { a[j] = *(const v2u*)(row + (hq + 4 * j) * 128); bq[j] = *(const v2u*)(row + (hq + 4 * j) * 128 + 64); }
#pragma unroll
        for (int j = 0; j < 5; ++j) {
            const float x1[4] = {bflo(a[j].x), bfhi(a[j].x), bflo(a[j].y), bfhi(a[j].y)}, x2[4] = {bflo(bq[j].x), bfhi(bq[j].x), bflo(bq[j].y), bfhi(bq[j].y)};
            v2u o1, o2; o1.x = pk2(x1[0] * cs[0] - x2[0] * sn[0], x1[1] * cs[1] - x2[1] * sn[1]); o1.y = pk2(x1[2] * cs[2] - x2[2] * sn[2], x1[3] * cs[3] - x2[3] * sn[3]);
            o2.x = pk2(x2[0] * cs[0] + x1[0] * sn[0], x2[1] * cs[1] + x1[1] * sn[1]); o2.y = pk2(x2[2] * cs[2] + x1[2] * sn[2], x2[3] * cs[3] + x1[3] * sn[3]);
            *(v2u*)(row + (hq + 4 * j) * 128) = o1; *(v2u*)(row + (hq + 4 * j) * 128 + 64) = o2; }
    }
}

__device__ __forceinline__ int scan_row(int s, int d, int b) {
    if (s < LC) { const int l = d ? (LC - 1 - s) : s; return M_LAT + b * LC + l; }
    const int t = d ? (T - 1 - (s - LC)) : (s - LC); return b * T + t;
}
constexpr int SL_KT = 0, SL_RT = 2048, SL_T = 4096, SL_KK = 4608, SL_KR = 5120, SL_BR = 5632, SL_A2 = 6144, SL_V = 10240, SL_GC = 12288, SLOT_BYTES = 12544;
constexpr int NPREP = 6, NSEQ = 2;
constexpr int PRIV_OFF = NPREP * SLOT_BYTES, PRIV_BYTES = 13376, PV_INVN = 12288, PV_COEF = 12352;
static_assert(PRIV_OFF + NPREP * PRIV_BYTES <= LDSCTL_OFF, "scan LDS");
constexpr int NCHUNK = (LC + T) / 16, NROUND = NCHUNK / NPREP;
static_assert(NROUND * NPREP == NCHUNK && NPREP + NSEQ == NWAVES && NSEQ == 2 && NPREP == 6, "scan roles");

__device__ __forceinline__ void p5_scan(Frame& F) {
    const int sid = F.blk, b = sid >> 6, h = (sid >> 1) & 31, d = sid & 1, lane = F.lane, l16 = lane & 15, gq = lane >> 4;
    const bool is_prep = F.wave >= NSEQ; const int pw = is_prep ? F.wave - NSEQ : 0;
    LAS unsigned char* slots = F.lds + RING_OFF;
    LAS unsigned char* priv = F.lds + RING_OFF + PRIV_OFF + pw * PRIV_BYTES;
    const bf16* Rb = (const bf16*)(F.ws + WS_R); const bf16* Kb = (const bf16*)(F.ws + WS_K); const bf16* Vb = (const bf16*)(F.ws + WS_V);
    const bf16* ICL = (const bf16*)(F.ws + WS_ICLR) + (size_t)d * M_ALL * C; const bf16* DEC = (const bf16*)(F.ws + WS_DEC) + (size_t)d * M_ALL * C;
    const float* INVN = (const float*)(F.ws + WS_INVN);
    bf16* Y = (bf16*)F.out + (size_t)d * M_LAT * C;
    const int ch = h * HS + lane;
    const float kkc = F.in[I_KK][ch], kac = F.in[I_KA][ch];
    v2u pr[5][4]; float pinv = 0.f;
#pragma unroll
    for (int x = 0; x < 5; ++x)
#pragma unroll
        for (int i = 0; i < 4; ++i) pr[x][i] = (v2u){0u, 0u};
#define SCAN_LOAD(c_) do { _Pragma("unroll") for (int i_ = 0; i_ < 4; ++i_) { \
        const int m_ = scan_row((c_) * 16 + 4 * i_ + gq, d, b); const size_t o_ = (size_t)m_ * C + h * HS + 4 * l16; \
        pr[0][i_] = *(const v2u*)(Rb + o_); pr[1][i_] = *(const v2u*)(Kb + o_); pr[2][i_] = *(const v2u*)(Vb + o_); pr[3][i_] = *(const v2u*)(ICL + o_); pr[4][i_] = *(const v2u*)(DEC + o_); } \
        pinv = INVN[(size_t)scan_row((c_) * 16 + l16, d, b) * NH + h]; } while (0)
    if (is_prep) SCAN_LOAD(pw);
    f32x4 Sacc[4][2];
#pragma unroll
    for (int mt = 0; mt < 4; ++mt) { Sacc[mt][0] = (f32x4){0.f, 0.f, 0.f, 0.f}; Sacc[mt][1] = (f32x4){0.f, 0.f, 0.f, 0.f}; }
    float Tcol[16]; f32x4 gKK = {0.f, 0.f, 0.f, 0.f}, gKR = gKK, gBR = gKK;
#pragma unroll
    for (int t = 0; t < 16; ++t) Tcol[t] = 0.f;

#define SC_TKF(base_, kp_) ({ const int tro_ = (l16 >> 2) * 32 + (l16 & 3) * 8; \
        const s16x4 lo_ = __builtin_amdgcn_ds_read_tr16_b64_v4i16((LAS s16x4*)(sl_ + (base_) + (32 * (kp_) + 4 * gq) * 32 + tro_)), hi_ = __builtin_amdgcn_ds_read_tr16_b64_v4i16((LAS s16x4*)(sl_ + (base_) + (32 * (kp_) + 16 + 4 * gq) * 32 + tro_)); \
        (bf16x8){lo_[0], lo_[1], lo_[2], lo_[3], hi_[0], hi_[1], hi_[2], hi_[3]}; })
#define SC_PERM2(base_) (*(const LAS v2u*)(sl_ + (base_) + l16 * 32 + gq * 8))
#define SC_PF(x_) __builtin_bit_cast(bf16x8, (v4u){(x_).x, (x_).y, 0u, 0u})
    struct ScEarly { bf16x8 kt0, kt1, rt0, rt1; v2u pkk, pkr, ptt, pbr, vb[2]; };
#define SC_LOAD_EARLY(E_, slot_) do { const LAS unsigned char* sl_ = slots + (slot_) * SLOT_BYTES; int lo_ = F.lane; asm volatile("" : "+v"(lo_)); const int l16 = lo_ & 15, gq = lo_ >> 4; \
        (E_).kt0 = SC_TKF(SL_KT, 0); (E_).kt1 = SC_TKF(SL_KT, 1); (E_).rt0 = SC_TKF(SL_RT, 0); (E_).rt1 = SC_TKF(SL_RT, 1); \
        (E_).pkk = SC_PERM2(SL_KK); (E_).pkr = SC_PERM2(SL_KR); (E_).ptt = SC_PERM2(SL_T); (E_).pbr = SC_PERM2(SL_BR); \
        (E_).vb[0] = *(const LAS v2u*)(sl_ + SL_V + (32 * F.wave + l16) * 32 + gq * 8); (E_).vb[1] = *(const LAS v2u*)(sl_ + SL_V + (32 * F.wave + 16 + l16) * 32 + gq * 8); } while (0)
#define SCAN_CONSUME(c_, slot_, E_) do { \
        const LAS unsigned char* sl_ = slots + (slot_) * SLOT_BYTES; const int wv_ = F.wave; int lo_ = F.lane; asm volatile("" : "+v"(lo_)); const int l16 = lo_ & 15, gq = lo_ >> 4; \
        const f32x4 z4_ = {0.f, 0.f, 0.f, 0.f}; \
        bf16x8 Af_[4]; f32x4 gc_[4]; \
        _Pragma("unroll") for (int mt = 0; mt < 4; ++mt) { Af_[mt] = *(const LAS bf16x8*)(sl_ + SL_A2 + (16 * mt + l16) * 64 + gq * 16); gc_[mt] = *(const LAS f32x4*)(sl_ + SL_GC + (16 * mt + 4 * gq) * 4); } \
        const bf16x8 pkk_ = SC_PF((E_).pkk), pkr_ = SC_PF((E_).pkr), ptt_ = SC_PF((E_).ptt), pbr_ = SC_PF((E_).pbr); \
        bf16x8 Bf_[2]; \
        _Pragma("unroll") for (int nt = 0; nt < 2; ++nt) { \
            bf16x8 Sb_[2]; \
            _Pragma("unroll") for (int kp = 0; kp < 2; ++kp) { v4u w_; w_.x = pk2(Sacc[2 * kp][nt][0], Sacc[2 * kp][nt][1]); w_.y = pk2(Sacc[2 * kp][nt][2], Sacc[2 * kp][nt][3]); \
                w_.z = pk2(Sacc[2 * kp + 1][nt][0], Sacc[2 * kp + 1][nt][1]); w_.w = pk2(Sacc[2 * kp + 1][nt][2], Sacc[2 * kp + 1][nt][3]); Sb_[kp] = __builtin_bit_cast(bf16x8, w_); } \
            const int vcol_ = 32 * wv_ + 16 * nt + l16; \
            const v2u vb_ = (E_).vb[nt]; \
            const bf16x8 Vb8_ = __builtin_bit_cast(bf16x8, (v4u){vb_.x, vb_.y, vb_.x, vb_.y}); \
            f32x4 Ut_ = __builtin_amdgcn_mfma_f32_16x16x32_bf16(pkk_, Vb8_, z4_, 0, 0, 0); \
            Ut_ = __builtin_amdgcn_mfma_f32_16x16x32_bf16((E_).kt0, Sb_[0], Ut_, 0, 0, 0); \
            Ut_ = __builtin_amdgcn_mfma_f32_16x16x32_bf16((E_).kt1, Sb_[1], Ut_, 0, 0, 0); \
            f32x4 Ya_ = __builtin_amdgcn_mfma_f32_16x16x32_bf16(pkr_, Vb8_, z4_, 0, 0, 0); \
            Ya_ = __builtin_amdgcn_mfma_f32_16x16x32_bf16((E_).rt0, Sb_[0], Ya_, 0, 0, 0); \
            Ya_ = __builtin_amdgcn_mfma_f32_16x16x32_bf16((E_).rt1, Sb_[1], Ya_, 0, 0, 0); \
            const unsigned ut0_ = pk2(Ut_[0], Ut_[1]), ut1_ = pk2(Ut_[2], Ut_[3]); \
            const f32x4 U_ = __builtin_amdgcn_mfma_f32_16x16x32_bf16(ptt_, __builtin_bit_cast(bf16x8, (v4u){ut0_, ut1_, ut0_, ut1_}), z4_, 0, 0, 0); \
            const unsigned u0_ = pk2(U_[0], U_[1]), u1_ = pk2(U_[2], U_[3]); \
            Ya_ = __builtin_amdgcn_mfma_f32_16x16x32_bf16(pbr_, __builtin_bit_cast(bf16x8, (v4u){u0_, u1_, u0_, u1_}), Ya_, 0, 0, 0); \
            if ((c_) >= LC / 16) { const int R_ = b * T + (d ? (T - 16 - ((c_) * 16 - LC)) : ((c_) * 16 - LC));     \
                const int grp_ = (R_ >> 2) + (d ? 3 - gq : gq); const f32x4 yv_ = d ? (f32x4){Ya_[3], Ya_[2], Ya_[1], Ya_[0]} : Ya_; \
                v2u yw_; yw_.x = pk2(yv_[0], yv_[1]); yw_.y = pk2(yv_[2], yv_[3]); *(v2u*)(Y + ((size_t)grp_ * C + h * HS + vcol_) * 4) = yw_; } \
            Bf_[nt] = __builtin_bit_cast(bf16x8, (v4u){vb_.x, vb_.y, u0_, u1_}); } \
        _Pragma("unroll") for (int mt = 0; mt < 4; ++mt) { \
            Sacc[mt][0] = __builtin_amdgcn_mfma_f32_16x16x32_bf16(Af_[mt], Bf_[0], Sacc[mt][0] * gc_[mt], 0, 0, 0); \
            Sacc[mt][1] = __builtin_amdgcn_mfma_f32_16x16x32_bf16(Af_[mt], Bf_[1], Sacc[mt][1] * gc_[mt], 0, 0, 0); } \
    } while (0)
#define SCAN_CONSUME_ROUND(c0_) do { ScEarly ea_, eb_; SC_LOAD_EARLY(ea_, 0); \
        SC_LOAD_EARLY(eb_, 1); SCAN_CONSUME((c0_) + 0, 0, ea_); SC_LOAD_EARLY(ea_, 2); SCAN_CONSUME((c0_) + 1, 1, eb_); SC_LOAD_EARLY(eb_, 3); SCAN_CONSUME((c0_) + 2, 2, ea_); \
        SC_LOAD_EARLY(ea_, 4); SCAN_CONSUME((c0_) + 3, 3, eb_); SC_LOAD_EARLY(eb_, 5); SCAN_CONSUME((c0_) + 4, 4, ea_); SCAN_CONSUME((c0_) + 5, 5, eb_); } while (0)

    if (is_prep) {
        for (int r = 0; r < NROUND; ++r) {
            const int c = NPREP * r + pw;
            int lane_o = F.lane; asm volatile("" : "+v"(lane_o));
            const int lane = lane_o, l16 = lane & 15, gq = lane >> 4;
#pragma unroll
            for (int i = 0; i < 4; ++i) { const int tt = 4 * i + gq;
#pragma unroll
                for (int x = 0; x < 5; ++x) *(LAS v2u*)(priv + x * 2048 + tt * 128 + l16 * 8) = pr[x][i]; }
            if (lane < 16) *(LAS float*)(priv + PV_INVN + 4 * lane) = pinv;
            LDS_WAIT();
            if (r + 1 < NROUND) SCAN_LOAD(c + NPREP);
            float g = 1.f; v4u vpk[2], okt[2], ort[2], obt[2], okd[2]; unsigned bkp[16];
            f32x4 inv4[4];
#pragma unroll
            for (int i = 0; i < 4; ++i) inv4[i] = *(const LAS f32x4*)(priv + PV_INVN + 16 * i);
#pragma unroll
            for (int hf = 0; hf < 2; ++hf) {
                float rr[8], kk[8], vv[8], ic[8], ww[8];
                {
                    const int rawo = (l16 >> 2) * 128 + gq * 32 + (l16 & 3) * 8;
#pragma unroll
                    for (int q4 = 0; q4 < 2; ++q4) { const int R0 = 8 * hf + 4 * q4;
                        const s16x4 r4 = __builtin_amdgcn_ds_read_tr16_b64_v4i16((LAS s16x4*)(priv + R0 * 128 + rawo)), k4 = __builtin_amdgcn_ds_read_tr16_b64_v4i16((LAS s16x4*)(priv + 2048 + R0 * 128 + rawo));
                        const s16x4 v4 = __builtin_amdgcn_ds_read_tr16_b64_v4i16((LAS s16x4*)(priv + 4096 + R0 * 128 + rawo)), i4 = __builtin_amdgcn_ds_read_tr16_b64_v4i16((LAS s16x4*)(priv + 6144 + R0 * 128 + rawo));
                        const s16x4 e4 = __builtin_amdgcn_ds_read_tr16_b64_v4i16((LAS s16x4*)(priv + 8192 + R0 * 128 + rawo));
#pragma unroll
                        for (int e = 0; e < 4; ++e) { rr[4 * q4 + e] = bf2f((bf16)r4[e]); kk[4 * q4 + e] = bf2f((bf16)k4[e]); vv[4 * q4 + e] = bf2f((bf16)v4[e]); ic[4 * q4 + e] = bf2f((bf16)i4[e]); ww[4 * q4 + e] = __expf(-bf2f((bf16)e4[e])); } }
                }
                LDS_WAIT();
                float kt8[8], rt8[8], bt8[8], kd8[8];
#pragma unroll
                for (int u = 0; u < 8; ++u) { const int t = 8 * hf + u;
                    const float kap = kk[u] * kkc * inv4[t >> 2][t & 3], kd = kk[u] * (1.0f + (ic[u] - 1.0f) * kac), bet = kap * ic[u];
                    const float gp = g; g *= ww[u]; const float ig = __builtin_amdgcn_rcpf(g);
                    kt8[u] = kap * gp; rt8[u] = rr[u] * g; bt8[u] = bet * ig; kd8[u] = kd * ig; bkp[t] = pk2(bt8[u], kd8[u]); }
                okt[hf].x = pk2(kt8[0], kt8[1]); okt[hf].y = pk2(kt8[2], kt8[3]); okt[hf].z = pk2(kt8[4], kt8[5]); okt[hf].w = pk2(kt8[6], kt8[7]);
                ort[hf].x = pk2(rt8[0], rt8[1]); ort[hf].y = pk2(rt8[2], rt8[3]); ort[hf].z = pk2(rt8[4], rt8[5]); ort[hf].w = pk2(rt8[6], rt8[7]);
                obt[hf].x = pk2(bt8[0], bt8[1]); obt[hf].y = pk2(bt8[2], bt8[3]); obt[hf].z = pk2(bt8[4], bt8[5]); obt[hf].w = pk2(bt8[6], bt8[7]);
                okd[hf].x = pk2(kd8[0], kd8[1]); okd[hf].y = pk2(kd8[2], kd8[3]); okd[hf].z = pk2(kd8[4], kd8[5]); okd[hf].w = pk2(kd8[6], kd8[7]);
                vpk[hf].x = pk2(vv[0], vv[1]); vpk[hf].y = pk2(vv[2], vv[3]); vpk[hf].z = pk2(vv[4], vv[5]); vpk[hf].w = pk2(vv[6], vv[7]);
            }
            asm volatile("" ::: "memory");
#pragma unroll
            for (int hf = 0; hf < 2; ++hf) { *(LAS v4u*)(priv + lane * 32 + 16 * hf) = okt[hf]; *(LAS v4u*)(priv + 2048 + lane * 32 + 16 * hf) = ort[hf]; *(LAS v4u*)(priv + 4096 + lane * 32 + 16 * hf) = obt[hf]; *(LAS v4u*)(priv + 6144 + lane * 32 + 16 * hf) = okd[hf]; }
            *(LAS v4u*)(priv + 8192 + lane * 32) = vpk[0]; *(LAS v4u*)(priv + 8192 + lane * 32 + 16) = vpk[1]; *(LAS float*)(priv + 10240 + 4 * lane) = g;
            f32x4 gN = {0.f, 0.f, 0.f, 0.f}; gKK = gN; gKR = gN; gBR = gN;
            const int troff = (l16 >> 2) * 32 + (l16 & 3) * 8;
#pragma unroll
            for (int ks = 0; ks < 2; ++ks) { const int off = (32 * ks + 8 * gq) * 32 + troff;
#define SC_TRF(base_) ({ const s16x4 lo_ = __builtin_amdgcn_ds_read_tr16_b64_v4i16((LAS s16x4*)(priv + (base_) + off)), hi_ = __builtin_amdgcn_ds_read_tr16_b64_v4i16((LAS s16x4*)(priv + (base_) + off + 128)); (bf16x8){lo_[0], lo_[1], lo_[2], lo_[3], hi_[0], hi_[1], hi_[2], hi_[3]}; })
                const bf16x8 a1 = SC_TRF(0), a2 = SC_TRF(2048), b1 = SC_TRF(4096), b2 = SC_TRF(6144);
#undef SC_TRF
                gN = __builtin_amdgcn_mfma_f32_16x16x32_bf16(a1, b1, gN, 0, 0, 0); gKK = __builtin_amdgcn_mfma_f32_16x16x32_bf16(a1, b2, gKK, 0, 0, 0);
                gKR = __builtin_amdgcn_mfma_f32_16x16x32_bf16(a2, b2, gKR, 0, 0, 0); gBR = __builtin_amdgcn_mfma_f32_16x16x32_bf16(a2, b1, gBR, 0, 0, 0); }
            LAS float* coef = (LAS float*)(priv + PV_COEF);
#pragma unroll
            for (int e = 0; e < 4; ++e) { const int t = 4 * gq + e; const bool lt = l16 < t, le = l16 <= t;
                coef[t * 16 + l16] = lt ? gN[e] : 0.f; gKK[e] = lt ? gKK[e] : 0.f; gKR[e] = le ? gKR[e] : 0.f; gBR[e] = le ? -gBR[e] : 0.f; }
#pragma unroll
            for (int g4 = 0; g4 < 4; ++g4) { float kd4[4], bt4[4];
#pragma unroll
                for (int j = 0; j < 4; ++j) { const unsigned w = bkp[4 * g4 + j]; bt4[j] = -g * bflo(w); kd4[j] = g * bfhi(w); }
                v4u a2; a2.x = pk2(kd4[0], kd4[1]); a2.y = pk2(kd4[2], kd4[3]); a2.z = pk2(bt4[0], bt4[1]); a2.w = pk2(bt4[2], bt4[3]);
                *(LAS v4u*)(priv + 4096 + lane * 64 + g4 * 16) = a2; }
            LDS_WAIT();
            f32x2 T2[8];
#pragma unroll
            for (int i = 0; i < 8; ++i) T2[i] = (f32x2){0.f, 0.f};
#pragma unroll
            for (int t = 0; t < 16; ++t) {
                f32x2 a2 = {(l16 == t) ? 1.0f : 0.0f, 0.f};
#pragma unroll
                for (int s4 = 0; s4 < (t + 3) / 4; ++s4) { const f32x4 cn = *(const LAS f32x4*)(coef + t * 16 + 4 * s4);
                    a2 -= (f32x2){cn[0], cn[1]} * T2[2 * s4]; if (4 * s4 + 2 < t) a2 -= (f32x2){cn[2], cn[3]} * T2[2 * s4 + 1]; }
                const float tv = a2.x + a2.y; Tcol[t] = tv; if (t & 1) T2[t >> 1].y = tv; else T2[t >> 1].x = tv;
            }
            asm volatile("s_waitcnt lgkmcnt(0)\n\ts_barrier" ::: "memory");
            {
            LAS unsigned char* sl = slots + pw * SLOT_BYTES; int lane_o = F.lane; asm volatile("" : "+v"(lane_o)); const int lane = lane_o, l16 = lane & 15, gq = lane >> 4;
            { const v4u k0 = *(const LAS v4u*)(priv + lane * 32), k1 = *(const LAS v4u*)(priv + lane * 32 + 16), r0 = *(const LAS v4u*)(priv + 2048 + lane * 32), r1 = *(const LAS v4u*)(priv + 2048 + lane * 32 + 16);
              *(LAS v4u*)(sl + SL_KT + lane * 32) = k0; *(LAS v4u*)(sl + SL_KT + lane * 32 + 16) = k1; *(LAS v4u*)(sl + SL_RT + lane * 32) = r0; *(LAS v4u*)(sl + SL_RT + lane * 32 + 16) = r1; }
            if (gq == 0) {
#pragma unroll
                for (int t = 0; t < 16; ++t) *(LAS bf16*)(sl + SL_T + t * 32 + 2 * l16) = (bf16)f2bf(Tcol[t]); }
#pragma unroll
            for (int e = 0; e < 4; ++e) { const int t = 4 * gq + e;
                *(LAS bf16*)(sl + SL_KK + t * 32 + 2 * l16) = (bf16)f2bf(gKK[e]); *(LAS bf16*)(sl + SL_KR + t * 32 + 2 * l16) = (bf16)f2bf(gKR[e]); *(LAS bf16*)(sl + SL_BR + t * 32 + 2 * l16) = (bf16)f2bf(gBR[e]); }
            { const v4u v0 = *(const LAS v4u*)(priv + 8192 + lane * 32), v1 = *(const LAS v4u*)(priv + 8192 + lane * 32 + 16); const float gc = *(const LAS float*)(priv + 10240 + 4 * lane);
              *(LAS v4u*)(sl + SL_V + lane * 32) = v0; *(LAS v4u*)(sl + SL_V + lane * 32 + 16) = v1; *(LAS float*)(sl + SL_GC + 4 * lane) = gc; }
#pragma unroll
            for (int g4 = 0; g4 < 4; ++g4) *(LAS v4u*)(sl + SL_A2 + lane * 64 + g4 * 16) = *(const LAS v4u*)(priv + 4096 + lane * 64 + g4 * 16);
            }
            asm volatile("s_waitcnt lgkmcnt(0)\n\ts_barrier" ::: "memory");
        }
    } else {
        for (int r = 0; r < NROUND; ++r) {
            if (r > 0) SCAN_CONSUME_ROUND(NPREP * (r - 1));
            asm volatile("s_waitcnt lgkmcnt(0)\n\ts_barrier" ::: "memory");
            asm volatile("s_waitcnt lgkmcnt(0)\n\ts_barrier" ::: "memory");
        }
        SCAN_CONSUME_ROUND(NPREP * (NROUND - 1));
    }
#undef SCAN_LOAD
#undef SCAN_CONSUME
#undef SC_TKF
#undef SC_PERM2
#undef SC_PF
#undef SC_LOAD_EARLY
#undef SCAN_CONSUME_ROUND
}

__device__ __forceinline__ unsigned att_off(unsigned row, unsigned ch) { return 256u * row + 16u * (ch ^ (((row & 3u) << 2) | ((row >> 2) & 3u))); }
constexpr int ATT_KV_BYTES = 16384, ATT_BUF_BYTES = 2 * ATT_KV_BYTES;
__device__ __forceinline__ void attn_tile_info(int ti, int n, int b, int& krow0, int& mode) {
    if (ti < 2) { krow0 = b * T + n * 128 + ti * 64; mode = 0; }
    else if (ti < 6) { krow0 = M_LAT + b * LC + (ti - 2) * 64; mode = 0; }
    else if (ti < 8) { krow0 = b * T + (n - 1) * 128 + (ti - 6) * 64; mode = (n == 0) ? -1 : 1; }
    else { krow0 = b * T + (n + 1) * 128 + (ti - 8) * 64; mode = (n == 63) ? -1 : 2; }
}
__device__ __forceinline__ void attn_stage(Frame& F, const bf16* QKV, int krow0, int hk, int buf) {
    const int lane = F.lane, cpos = lane & 15;
#pragma unroll
    for (int i = 0; i < 2; ++i) { const int piece = F.wave * 2 + i, row = piece * 4 + (lane >> 4);
        const int ch = cpos ^ (((row & 3) << 2) | ((row >> 2) & 3));
        const int vkey = 32 * (row >> 5) + 16 * ((row >> 2) & 1) + 4 * ((row >> 3) & 3) + (row & 3);
        LAS unsigned char* kd = F.lds + RING_OFF + buf * ATT_BUF_BYTES + piece * 1024;
        __builtin_amdgcn_global_load_lds((const unsigned*)(QKV + (size_t)(krow0 + row) * NQKV + 2048 + hk * 128 + ch * 8), (LAS unsigned*)kd, 16, 0, 0);
        __builtin_amdgcn_global_load_lds((const unsigned*)(QKV + (size_t)(krow0 + vkey) * NQKV + 2560 + hk * 128 + ch * 8), (LAS unsigned*)(kd + ATT_KV_BYTES), 16, 0, 0); }
}
__device__ __forceinline__ void attn_unit(Frame& F, int unit) {
    const int hh = unit & 1, hk = (unit >> 1) & 3, n = (unit >> 3) & 63, b = unit >> 9;
    const int w = F.wave, lane = F.lane, l16 = lane & 15, gq = lane >> 4;
    const int head = hk * 4 + hh * 2 + (w >> 2), qoff = (w & 3) * 32;
    const bf16* QKV = (const bf16*)(F.ws + WS_IPQKV);
    const float sink = F.in[I_SINK][head];
    const float scale_l2 = 0.08838834764831845f * 1.4426950408889634f;
    __syncthreads();
    attn_stage(F, QKV, b * T + n * 128, hk, 0);
    bf16x8 qf[2][4];
#pragma unroll
    for (int nt = 0; nt < 2; ++nt)
#pragma unroll
        for (int ks = 0; ks < 4; ++ks) qf[nt][ks] = *(const bf16x8*)(QKV + (size_t)(b * T + n * 128 + qoff + nt * 16 + l16) * NQKV + head * 128 + ks * 32 + gq * 8);
    f32x4 oacc[8][2];
#pragma unroll
    for (int dm = 0; dm < 8; ++dm) { oacc[dm][0] = (f32x4){0.f, 0.f, 0.f, 0.f}; oacc[dm][1] = (f32x4){0.f, 0.f, 0.f, 0.f}; }
    float mrun[2] = {-1e30f, -1e30f}, lrun[2] = {0.f, 0.f};
    const int cnt = 10 - (n == 0 ? 2 : 0) - (n == 63 ? 2 : 0);
    { int kr1, md1; attn_tile_info(1, n, b, kr1, md1); attn_stage(F, QKV, kr1, hk, 1); }
    asm volatile("s_waitcnt vmcnt(4)" ::: "memory"); __syncthreads();
    int pb = 0;
    for (int i = 0; i < cnt; ++i) {
        const int ti = (n == 0 && i >= 6) ? i + 2 : i;
        int krow0, mode; attn_tile_info(ti, n, b, krow0, mode);
        const bool more = i + 2 < cnt;
        if (more) { const int tn = (n == 0 && i + 2 >= 6) ? i + 4 : i + 2; int kr2, md2; attn_tile_info(tn, n, b, kr2, md2); attn_stage(F, QKV, kr2, hk, pb >= 1 ? pb - 1 : 2); }
        {
            const LAS unsigned char* Kimg = F.lds + RING_OFF + pb * ATT_BUF_BYTES; const LAS unsigned char* Vimg = Kimg + ATT_KV_BYTES;
            const int joff = (ti & 1) * 64;
            f32x4 sacc[4][2];
#pragma unroll
            for (int mt = 0; mt < 4; ++mt) { sacc[mt][0] = (f32x4){0.f, 0.f, 0.f, 0.f}; sacc[mt][1] = (f32x4){0.f, 0.f, 0.f, 0.f}; }
#pragma unroll
            for (int ks = 0; ks < 4; ++ks)
#pragma unroll
                for (int mt = 0; mt < 4; ++mt) { const bf16x8 kf = *(const LAS bf16x8*)(Kimg + att_off((unsigned)(mt * 16 + l16), (unsigned)(4 * ks + gq)));
                    sacc[mt][0] = __builtin_amdgcn_mfma_f32_16x16x32_bf16(kf, qf[0][ks], sacc[mt][0], 0, 0, 0);
                    sacc[mt][1] = __builtin_amdgcn_mfma_f32_16x16x32_bf16(kf, qf[1][ks], sacc[mt][1], 0, 0, 0); }
            bf16x8 pf[2][2];
#pragma unroll
            for (int nt = 0; nt < 2; ++nt) {
                const int qi = qoff + nt * 16 + l16;
                float mx = -1e30f, sc = scale_l2;
                if (mode == 0) {
#pragma unroll
                    for (int mt = 0; mt < 4; ++mt)
#pragma unroll
                        for (int e = 0; e < 4; ++e) mx = fmaxf(mx, sacc[mt][nt][e]);
                    mx *= scale_l2;
                } else {
                    const int bs = joff + 4 * gq - qi;
                    if (mode == 1) {
#pragma unroll
                        for (int mt = 0; mt < 4; ++mt)
#pragma unroll
                            for (int e = 0; e < 4; ++e) { float s = sacc[mt][nt][e] * scale_l2; if (bs < -(mt * 16 + e)) s = -1e30f; sacc[mt][nt][e] = s; mx = fmaxf(mx, s); }
                    } else {
#pragma unroll
                        for (int mt = 0; mt < 4; ++mt)
#pragma unroll
                            for (int e = 0; e < 4; ++e) { float s = sacc[mt][nt][e] * scale_l2; if (mode == 2 && bs > -(mt * 16 + e)) s = -1e30f; sacc[mt][nt][e] = s; mx = fmaxf(mx, s); }
                    }
                    sc = 1.0f;
                }
                mx = rows_max(mx);
                const float mnew = fmaxf(mrun[nt], mx), alpha = __builtin_amdgcn_exp2f(mrun[nt] - mnew);
                float ps = 0.f; float p[4][4];
#pragma unroll
                for (int mt = 0; mt < 4; ++mt)
#pragma unroll
                    for (int e = 0; e < 4; ++e) { p[mt][e] = __builtin_amdgcn_exp2f(fmaf(sacc[mt][nt][e], sc, -mnew)); ps += p[mt][e]; }
                ps = rows_sum(ps);
                lrun[nt] = lrun[nt] * alpha + ps; mrun[nt] = mnew;
#pragma unroll
                for (int dm = 0; dm < 8; ++dm) oacc[dm][nt] = oacc[dm][nt] * alpha;
#pragma unroll
                for (int kp = 0; kp < 2; ++kp) { v4u wv; wv.x = pk2(p[2 * kp][0], p[2 * kp][1]); wv.y = pk2(p[2 * kp][2], p[2 * kp][3]); wv.z = pk2(p[2 * kp + 1][0], p[2 * kp + 1][1]); wv.w = pk2(p[2 * kp + 1][2], p[2 * kp + 1][3]);
                    pf[nt][kp] = __builtin_bit_cast(bf16x8, wv); }
            }
            const unsigned q4 = (unsigned)(l16 >> 2), p4 = (unsigned)(lane & 3);
#pragma unroll
            for (int dm = 0; dm < 8; ++dm)
#pragma unroll
                for (int kp = 0; kp < 2; ++kp) {
                    const s16x4 v0 = __builtin_amdgcn_ds_read_tr16_b64_v4i16((LAS s16x4*)(Vimg + att_off((unsigned)(32 * kp + 8 * gq) + q4, (unsigned)(2 * dm) + (p4 >> 1)) + 8u * (p4 & 1u)));
                    const s16x4 v1 = __builtin_amdgcn_ds_read_tr16_b64_v4i16((LAS s16x4*)(Vimg + att_off((unsigned)(32 * kp + 8 * gq + 4) + q4, (unsigned)(2 * dm) + (p4 >> 1)) + 8u * (p4 & 1u)));
                    const bf16x8 vf = (bf16x8){v0[0], v0[1], v0[2], v0[3], v1[0], v1[1], v1[2], v1[3]};
                    oacc[dm][0] = __builtin_amdgcn_mfma_f32_16x16x32_bf16(vf, pf[0][kp], oacc[dm][0], 0, 0, 0);
                    oacc[dm][1] = __builtin_amdgcn_mfma_f32_16x16x32_bf16(vf, pf[1][kp], oacc[dm][1], 0, 0, 0); }
        }
        if (more) asm volatile("s_waitcnt vmcnt(4)" ::: "memory"); else asm volatile("s_waitcnt vmcnt(0)" ::: "memory");
        __syncthreads();
        pb = pb == 2 ? 0 : pb + 1;
    }
    bf16* MA = (bf16*)(F.ws + WS_MA);
    const float sk2 = sink * 1.4426950408889634f;
#pragma unroll
    for (int nt = 0; nt < 2; ++nt) {
        const float mf = fmaxf(mrun[nt], sk2), a = exp2f(mrun[nt] - mf), l = lrun[nt] * a + exp2f(sk2 - mf), sc = a / l;
        bf16* orow = MA + (size_t)(b * T + n * 128 + qoff + nt * 16 + l16) * D + C + head * 128 + 4 * gq;
#pragma unroll
        for (int dm = 0; dm < 8; ++dm) { const f32x4 o = oacc[dm][nt] * sc; v2u wv; wv.x = pk2(o[0], o[1]); wv.y = pk2(o[2], o[3]); *(v2u*)(orow + dm * 16) = wv; }
    }
}

__device__ __forceinline__ void p7_rwkv_out(Frame& F) {
    const int gw = F.blk * NWAVES + F.wave, NGW = F.G * NWAVES, lane = F.lane;
    const bf16* Y0 = (const bf16*)F.out; const bf16* Y1 = Y0 + (size_t)M_LAT * C;
    const bf16* Vb = (const bf16*)(F.ws + WS_V); const float* BON = (const float*)(F.ws + WS_BONUS);
    const bf16* Gb = (const bf16*)(F.ws + WS_G); bf16* MA = (bf16*)(F.ws + WS_MA);
#pragma unroll 1
    for (int it = gw; it < (M_LAT / 4) * NH; it += NGW) {
        const int m0 = (it >> 5) * 4, h = it & 31, ch = h * HS + lane;
        const v2u ya = *(const v2u*)(Y0 + ((size_t)(m0 >> 2) * C + ch) * 4), yb = *(const v2u*)(Y1 + ((size_t)(m0 >> 2) * C + ch) * 4);
        const float ys[4] = {bflo(ya.x) + bflo(yb.x), bfhi(ya.x) + bfhi(yb.x), bflo(ya.y) + bflo(yb.y), bfhi(ya.y) + bfhi(yb.y)};
        float y[4], v[4], g[4], bonus[4];
#pragma unroll
        for (int u = 0; u < 4; ++u) { const size_t o = (size_t)(m0 + u) * C + ch;
            y[u] = ys[u]; v[u] = bf2f(Vb[o]); g[u] = bf2f(Gb[o]); bonus[u] = BON[(size_t)(m0 + u) * NH + h]; }
        const float gng = F.in[I_GNG][ch], gnb = F.in[I_GNB][ch];
#pragma unroll
        for (int u = 0; u < 4; ++u) {
            const float mu = wave_sum(y[u]) * (1.0f / 64.0f), dy = y[u] - mu, var = wave_sum(dy * dy) * (1.0f / 64.0f);
            const float yn = dy * (1.0f / sqrtf(var + GN_EPS)) * gng + gnb;
            MA[(size_t)(m0 + u) * D + ch] = (bf16)f2bf((yn + bonus[u] * v[u]) * g[u]); }
    }
}

__device__ __forceinline__ void p11_ln1(Frame& F) {
    const int gw = F.blk * NWAVES + F.wave, NGW = F.G * NWAVES, lane = F.lane;
    const float* Z = F.out; float* ST = (float*)(F.ws + WS_X1); bf16* H2 = (bf16*)(F.ws + WS_H2); const float* MOD = (const float*)(F.ws + WS_MOD);
    const float* lg = F.in[I_LN1G]; const float* lb = F.in[I_LN1B];
    for (int m = gw; m < M_LAT; m += NGW) {
        const float* z = Z + (size_t)m * D; f32x4 v[16]; float s = 0.f;
#pragma unroll
        for (int j = 0; j < 16; ++j) { v[j] = *(const f32x4*)(z + 4 * lane + 256 * j); s += (v[j][0] + v[j][1]) + (v[j][2] + v[j][3]); }
        const float mean = wave_sum(s) * (1.0f / D); float q = 0.f;
#pragma unroll
        for (int j = 0; j < 16; ++j) { v[j] = v[j] - mean; q += (v[j][0] * v[j][0] + v[j][1] * v[j][1]) + (v[j][2] * v[j][2] + v[j][3] * v[j][3]); }
        const float rstd = 1.0f / sqrtf(wave_sum(q) * (1.0f / D) + LN_EPS);
        const float* sh2 = MOD + (size_t)(m >> 13) * NMOD + 3 * D; const float* sc2 = sh2 + D;
        if (lane == 0) { ST[2 * m] = mean; ST[2 * m + 1] = rstd; } v2u* ho = (v2u*)(H2 + (size_t)m * D);
#pragma unroll
        for (int j = 0; j < 16; ++j) { const int c = 4 * lane + 256 * j;
            const f32x4 x1 = v[j] * rstd * *(const f32x4*)(lg + c) + *(const f32x4*)(lb + c);
            const f32x4 hv = x1 * (*(const f32x4*)(sc2 + c) + 1.0f) + *(const f32x4*)(sh2 + c);
            v2u w; w.x = pk2(hv[0], hv[1]); w.y = pk2(hv[2], hv[3]); ho[lane + 64 * j] = w; }
    }
}
__device__ __forceinline__ void p14_ln2(Frame& F) {
    const int gw = F.blk * NWAVES + F.wave, NGW = F.G * NWAVES, lane = F.lane;
    float* Z = F.out; const float* lg = F.in[I_LN2G]; const float* lb = F.in[I_LN2B];
    for (int m = gw; m < M_LAT; m += NGW) {
        float* z = Z + (size_t)m * D; f32x4 v[16]; float s = 0.f;
#pragma unroll
        for (int j = 0; j < 16; ++j) { v[j] = *(const f32x4*)(z + 4 * lane + 256 * j); s += (v[j][0] + v[j][1]) + (v[j][2] + v[j][3]); }
        const float mean = wave_sum(s) * (1.0f / D); float q = 0.f;
#pragma unroll
        for (int j = 0; j < 16; ++j) { v[j] = v[j] - mean; q += (v[j][0] * v[j][0] + v[j][1] * v[j][1]) + (v[j][2] * v[j][2] + v[j][3] * v[j][3]); }
        const float rstd = 1.0f / sqrtf(wave_sum(q) * (1.0f / D) + LN_EPS);
#pragma unroll
        for (int j = 0; j < 16; ++j) { const int c = 4 * lane + 256 * j; *(f32x4*)(z + c) = v[j] * rstd * *(const f32x4*)(lg + c) + *(const f32x4*)(lb + c); }
    }
}

struct Args { const float* in[29]; float* out; unsigned char* ws; int ph_lo, ph_hi; };
__global__ void __launch_bounds__(NTHR, 2) mk_fwd(Args args) {
    extern __shared__ __attribute__((aligned(16))) unsigned char lds[];
    Frame F;
    F.lds = (LAS unsigned char*)lds;
    F.tid = threadIdx.x; F.lane = F.tid & 63; F.wave = __builtin_amdgcn_readfirstlane(F.tid >> 6);
    F.G = gridDim.x; F.blk = blockIdx.x;
#pragma unroll
    for (int i = 0; i < 29; ++i) F.in[i] = args.in[i];
    F.out = args.out; F.ws = args.ws;
    volatile LAS unsigned* MISC = (volatile LAS unsigned*)(F.lds + MISC_OFF);
    for (int u = F.tid; u < (LDS_BYTES - LDSCTL_OFF) / 4; u += NTHR) ((LAS unsigned*)(F.lds + LDSCTL_OFF))[u] = 0u;
    __syncthreads();
    unsigned* ctl = (unsigned*)(F.ws + WS_CTL);
    XcdBarrier bar; bar.bar = ctl + CW_BAR; bar.x = 0; bar.st = nullptr;
    if (MK_N_LAUNCHES == 1) bar = xcd_barrier_post(ctl + CW_BAR, MISC + 8);
    const int lo = args.ph_lo, hi = args.ph_hi;
#define IN(k) (lo <= (k) && (k) < hi)
#define SEAM(k) do { if (IN(k) && IN((k) + 1)) xcd_barrier(bar); } while (0)
    LAS unsigned char* ring = F.lds + RING_OFF;
    bf16* W1 = (bf16*)(F.ws + WS_W1); bf16* H = (bf16*)(F.ws + WS_H);
    const float* MOD = (const float*)(F.ws + WS_MOD);

    if (IN(0)) { p0_convert_a(F); } SEAM(0);
    if (IN(1)) { p1_mod(F); } SEAM(1);
    if (IN(2)) { p2_modulate(F); } SEAM(2);
    if (IN(3)) {
        pg8::Gemm g{H, W1, M_ALL, N_INP, D, D, D}; pg8::InprojOrder S; S.init(F.G, F.blk);
        pg8::EpiInproj E{(bf16*)(F.ws + WS_IPRW), (bf16*)(F.ws + WS_IPQKV), (bf16*)(F.ws + WS_IPGATE), (const float*)(F.ws + WS_ROPE)};
        pg8::gemm_phase<pg8::EpiInproj, pg8::InprojOrder, true, true>(ring, g, S, E);
    } SEAM(3);
    if (IN(4)) { p4_features_mfma<0>(F, 0, F.G); }
    SEAM(5);
    if (IN(6)) {
        if (F.blk < 128) p5_scan(F);
        else { for (int u = F.blk - 128; u < 1024; u += F.G - 128) attn_unit(F, u); __syncthreads(); p4_features_mfma<1>(F, 128, F.G - 128); __syncthreads(); p_convert_ffn(F, 128, F.G - 128, 0); }
    } SEAM(6);
    if (IN(7)) { p7_rwkv_out(F); } SEAM(7);
    if (IN(8)) {
        pg8::Gemm g{(const bf16*)(F.ws + WS_MA), (const bf16*)(F.ws + WS_WOCAT), M_LAT, D, D, D, D}; pg8::StaticOrder S; S.init(M_LAT, D, F.G, F.blk);
        pg8::EpiGateMerged E{(const bf16*)(F.ws + WS_IPGATE), NGATE, (bf16*)(F.ws + WS_MERGED)};
        pg8::gemm_phase<pg8::EpiGateMerged, pg8::StaticOrder, true, true>(ring, g, S, E);
    } SEAM(8);
    if (IN(10)) {
        pg8::Gemm g{(const bf16*)(F.ws + WS_MERGED), (const bf16*)(F.ws + WS_WOUT), M_LAT, D, D, D, D}; pg8::StaticOrder S; S.init(M_LAT, D, F.G, F.blk);
        pg8::EpiResid E{F.in[I_X], F.out, MOD + 2 * D, NMOD, ALPHA};
        pg8::gemm_phase<pg8::EpiResid, pg8::StaticOrder, true, true>(ring, g, S, E);
    } SEAM(10);
    if (IN(11)) { p11_ln1(F); } SEAM(11);
    if (IN(12)) {
        pg8::Gemm g{(const bf16*)(F.ws + WS_H2), (const bf16*)(F.ws + WS_WGU), M_LAT, 2 * DFF, D, D, D}; pg8::StaticOrder S; S.init(M_LAT, 2 * DFF, F.G, F.blk);
        pg8::EpiSwiglu E{(bf16*)(F.ws + WS_ACT), DFF};
        pg8::gemm_phase<pg8::EpiSwiglu, pg8::StaticOrder, true, true>(ring, g, S, E);
        { const int tail = S.nwg % F.G;
          if (tail > 0 && F.blk >= tail) p_convert_ffn(F, tail, F.G - tail, 1); else if (tail == 0) p_convert_ffn(F, 0, F.G, 1); }
    } SEAM(12);
    if (IN(13)) {
        pg8::Gemm g{(const bf16*)(F.ws + WS_ACT), (const bf16*)(F.ws + WS_WDN), M_LAT, D, DFF, DFF, DFF}; pg8::StaticOrder S; S.init(M_LAT, D, F.G, F.blk);
        pg8::EpiResidLn E{F.out, (const float*)(F.ws + WS_X1), F.in[I_LN1G], F.in[I_LN1B], MOD + 5 * D, NMOD, ALPHA};
        pg8::gemm_phase<pg8::EpiResidLn, pg8::StaticOrder, true, true>(ring, g, S, E);
    } SEAM(13);
    if (IN(14)) { p14_ln2(F); }
#undef IN
#undef SEAM
}

extern "C" void kernel_launch(void* const* d_in, const int* in_sizes, int n_in, void* d_out, int out_size, void* d_ws, size_t ws_size, hipStream_t stream) {
    static int grid = 0;
    if (grid == 0) {
        if (n_in != 29 || in_sizes[0] != M_LAT * D || out_size != M_LAT * D || ws_size < WS_END) { fprintf(stderr, "kernel_launch: unexpected shapes (n_in %d, in0 %d, out %d, ws %zu < %zu)\n", n_in, n_in > 0 ? in_sizes[0] : -1, out_size, ws_size, (size_t)WS_END); grid = -1; return; }
        int dev = 0, cus = 0, per_cu = 0;
        if (hipGetDevice(&dev) != hipSuccess || hipDeviceGetAttribute(&cus, hipDeviceAttributeMultiprocessorCount, dev) != hipSuccess) { grid = -1; return; }
        if (hipFuncSetAttribute((const void*)mk_fwd, hipFuncAttributeMaxDynamicSharedMemorySize, LDS_BYTES) != hipSuccess) { fprintf(stderr, "kernel_launch: hipFuncSetAttribute failed\n"); grid = -1; return; }
        if (hipOccupancyMaxActiveBlocksPerMultiprocessor(&per_cu, (const void*)mk_fwd, NTHR, LDS_BYTES) != hipSuccess || per_cu < 1) fprintf(stderr, "kernel_launch: occupancy query reports %d\n", per_cu);
        (void)hipGetLastError();
        grid = cus;
        if (grid < 256) { fprintf(stderr, "kernel_launch: %d CUs < 256\n", grid); }
    }
    if (grid < 0) return;
    if (hipMemsetAsync((char*)d_ws + WS_CTL, 0, CTL_ZERO_BYTES, stream) != hipSuccess) return;
    Args a{};
    for (int i = 0; i < 29; ++i) a.in[i] = (const float*)d_in[i];
    a.out = (float*)d_out; a.ws = (unsigned char*)d_ws;
#if MK_N_LAUNCHES == 1
    a.ph_lo = 0; a.ph_hi = NPHASE;
    hipLaunchKernelGGL(mk_fwd, dim3(grid), dim3(NTHR), LDS_BYTES, stream, a);
#else
    for (int p = 0; p < NPHASE; ++p) for (int rep = 0; rep < 1 + ((REPMASK >> p) & 1); ++rep) { a.ph_lo = p; a.ph_hi = p + 1; hipLaunchKernelGGL(mk_fwd, dim3(grid), dim3(NTHR), LDS_BYTES, stream, a); }
#endif
}
```
